# Optimizing an MI355X kernel written in HIP

```python
import math
import jax
import jax.numpy as jnp
from jax import lax
import numpy as np

D_MODEL = 1024
BATCH = 8
SEQ = 2048
DEPTH = 2

GRID_W = 64
CTX_LEN = 256
HEAD_DIM = 64
DIFF_HEADS = 4
DIFF_V_DIM = 2 * HEAD_DIM
WIN_Q_HEADS = 8
WIN_KV_HEADS = 2
WINDOW = 128
WIN_BLOCK = 128
Q_BLOCK = 128
ROPE_BASE = 10000.0
DIFF_QK_W = DIFF_HEADS * 2 * HEAD_DIM
DIFF_VW = DIFF_HEADS * DIFF_V_DIM
WIN_Q_W = WIN_Q_HEADS * HEAD_DIM
WIN_KV_W = WIN_KV_HEADS * HEAD_DIM
Q_W = DIFF_QK_W + WIN_Q_W
KV_W = DIFF_QK_W + DIFF_VW + 2 * WIN_KV_W
ATTN_PROJ_W = Q_W + KV_W
MIX_W = DIFF_VW + WIN_Q_W
HYENA_ORDER = 2
SHORT_CONV = 3
FILTER_EMB = 33
FILTER_HID = 64
FILTER_OUT_SCALE = 0.05
DECAY_TARGET = 1e-2
FAST_DECAY_PCT = 0.3
SLOW_DECAY_PCT = 1.5
N_EXPERTS = 16
N_GROUPS = 4
EXPERTS_PER_GROUP = N_EXPERTS // N_GROUPS
TOP_K = 2
EXPERT_FF = 1024
MOE_BLOCK = 128
LN_EPS = 1e-5
DEEPNORM_ALPHA = (2 * DEPTH) ** 0.25
DEEPNORM_BETA = (8 * DEPTH) ** -0.25
NEG_INF = -1e30

kernel_name = 'hybrid_diffattn_wingqa_hyena_groupmoe'


def layer_norm(x, g, b):
    xf = x.astype(jnp.float32)
    mu = xf.mean(-1, keepdims=True)
    var = jnp.square(xf - mu).mean(-1, keepdims=True)
    y = (xf - mu) * lax.rsqrt(var + LN_EPS) * g.astype(jnp.float32) + b.astype(jnp.float32)
    return y.astype(x.dtype)


def rms_norm(x, g):
    xf = x.astype(jnp.float32)
    y = xf * lax.rsqrt(jnp.mean(jnp.square(xf), -1, keepdims=True) + LN_EPS) * g.astype(jnp.float32)
    return y.astype(x.dtype)


def axial_rope_tables(rows):
    r, col = jnp.meshgrid(jnp.arange(rows, dtype=jnp.float32), jnp.arange(GRID_W, dtype=jnp.float32), indexing='ij')
    axis_dim = HEAD_DIM // 2
    inv_freq = ROPE_BASE ** (-jnp.arange(0, axis_dim, 2, dtype=jnp.float32) / axis_dim)
    ang = jnp.concatenate([r.reshape(-1, 1) * inv_freq, col.reshape(-1, 1) * inv_freq], -1)
    ang = jnp.concatenate([ang, ang], -1)
    return jnp.cos(ang), jnp.sin(ang)


def apply_rope(x, cos, sin):
    shape = (1, cos.shape[0]) + (1,) * (x.ndim - 3) + (HEAD_DIM,)
    cos = cos.reshape(shape).astype(x.dtype)
    sin = sin.reshape(shape).astype(x.dtype)
    x1, x2 = jnp.split(x, 2, axis=-1)
    return x * cos + jnp.concatenate([-x2, x1], -1) * sin


def diff_attention(q, k, v, lam):
    b, n, h, _, d = q.shape
    nb = n // Q_BLOCK
    scale = d ** -0.5
    qb = jnp.moveaxis(q.reshape(b, nb, Q_BLOCK, h, 2, d), 1, 0)

    def block(q_blk):
        s = jnp.einsum('bqhmd,bkhmd->mbhqk', q_blk, k).astype(jnp.float32) * scale
        p = jax.nn.softmax(s, axis=-1)
        a = (p[0] - lam * p[1]).astype(v.dtype)
        return jnp.einsum('bhqk,bkhe->bqhe', a, v)

    o = lax.map(block, qb)
    return jnp.moveaxis(o, 0, 1).reshape(b, n, h, v.shape[-1])


def window_gqa_latent(q, k, v, k_ctx, v_ctx, sink):
    b, n, hq, d = q.shape
    nb = n // WIN_BLOCK
    g = hq // WIN_KV_HEADS
    scale = d ** -0.5
    qb = q.reshape(b, nb, WIN_BLOCK, WIN_KV_HEADS, g, d)

    def band(t):
        tp = jnp.pad(t, ((0, 0), (WIN_BLOCK, WIN_BLOCK), (0, 0), (0, 0))).reshape(b, nb + 2, WIN_BLOCK, WIN_KV_HEADS, d)
        return jnp.concatenate([tp[:, :-2], tp[:, 1:-1], tp[:, 2:]], axis=2)

    kb, vb = band(k), band(v)
    n_loc = 3 * WIN_BLOCK
    s_loc = jnp.einsum('bnqhgd,bnkhd->bnhgqk', qb, kb).astype(jnp.float32) * scale
    q_off = jnp.arange(WIN_BLOCK)[:, None] + WIN_BLOCK
    k_off = jnp.arange(n_loc)[None, :]
    k_abs = (jnp.arange(nb)[:, None] - 1) * WIN_BLOCK + k_off
    allowed = (jnp.abs(q_off - k_off) <= WINDOW)[None] & ((k_abs >= 0) & (k_abs < n))[:, None, :]
    s_loc = jnp.where(allowed[None, :, None, None], s_loc, NEG_INF)
    s_ctx = jnp.einsum('bnqhgd,bchd->bnhgqc', qb, k_ctx).astype(jnp.float32) * scale
    s_sink = jnp.broadcast_to(sink.astype(jnp.float32).reshape(WIN_KV_HEADS, g)[None, None, :, :, None, None], s_loc.shape[:-1] + (1,))
    p = jax.nn.softmax(jnp.concatenate([s_loc, s_ctx, s_sink], -1), axis=-1).astype(v.dtype)
    n_ctx = k_ctx.shape[1]
    o = jnp.einsum('bnhgqk,bnkhd->bnqhgd', p[..., :n_loc], vb) + jnp.einsum('bnhgqc,bchd->bnqhgd', p[..., n_loc:n_loc + n_ctx], v_ctx)
    return o.reshape(b, n, hq, d)


def gqa_sink_dense(q, k, v, sink):
    b, n, hq, d = q.shape
    g = hq // WIN_KV_HEADS
    qg = q.reshape(b, n, WIN_KV_HEADS, g, d)
    s = jnp.einsum('bqhgd,bkhd->bhgqk', qg, k).astype(jnp.float32) * d ** -0.5
    s_sink = jnp.broadcast_to(sink.astype(jnp.float32).reshape(WIN_KV_HEADS, g)[None, :, :, None, None], s.shape[:-1] + (1,))
    p = jax.nn.softmax(jnp.concatenate([s, s_sink], -1), axis=-1)[..., :-1].astype(v.dtype)
    return jnp.einsum('bhgqk,bkhd->bqhgd', p, v).reshape(b, n, hq, d)


def attention_group_mixer(h, h_ctx, w_in, lam_vec, subln_g, sink, w_out, lam_init, cos, sin, ctx_out):
    def split_q(cols):
        qa = cols[..., :DIFF_QK_W].reshape(cols.shape[:2] + (DIFF_HEADS, 2, HEAD_DIM))
        qw = cols[..., DIFF_QK_W:Q_W].reshape(cols.shape[:2] + (WIN_Q_HEADS, HEAD_DIM))
        return qa, qw

    def split_kv(cols):
        o1 = DIFF_QK_W
        o2 = o1 + DIFF_VW
        o3 = o2 + WIN_KV_W
        ka = cols[..., :o1].reshape(cols.shape[:2] + (DIFF_HEADS, 2, HEAD_DIM))
        va = cols[..., o1:o2].reshape(cols.shape[:2] + (DIFF_HEADS, DIFF_V_DIM))
        kw = cols[..., o2:o3].reshape(cols.shape[:2] + (WIN_KV_HEADS, HEAD_DIM))
        vw = cols[..., o3:].reshape(cols.shape[:2] + (WIN_KV_HEADS, HEAD_DIM))
        return ka, va, kw, vw

    lv = lam_vec.astype(jnp.float32)
    lam = jnp.exp(jnp.sum(lv[0] * lv[1])) - jnp.exp(jnp.sum(lv[2] * lv[3])) + lam_init

    def merge(oa, ow):
        oa = rms_norm(oa, subln_g) * (1.0 - lam_init)
        cat = jnp.concatenate([oa.reshape(oa.shape[:2] + (DIFF_VW,)), ow.reshape(ow.shape[:2] + (WIN_Q_W,))], -1)
        return cat @ w_out

    proj = h @ w_in
    proj_c = h_ctx @ (w_in if ctx_out else w_in[:, Q_W:])
    ka_c, va_c, kw_c, vw_c = split_kv(proj_c[..., -KV_W:])
    qa, qw = split_q(proj[..., :Q_W])
    ka, va, kw, vw = split_kv(proj[..., Q_W:])
    qa, ka, qw, kw = apply_rope(qa, cos, sin), apply_rope(ka, cos, sin), apply_rope(qw, cos, sin), apply_rope(kw, cos, sin)
    oa = diff_attention(qa, jnp.concatenate([ka, ka_c], 1), jnp.concatenate([va, va_c], 1), lam)
    ow = window_gqa_latent(qw, kw, vw, kw_c, vw_c, sink)
    y = merge(oa, ow)
    if ctx_out:
        qa_c, qw_c = split_q(proj_c[..., :Q_W])
        y_c = merge(diff_attention(qa_c, ka_c, va_c, lam), gqa_sink_dense(qw_c, kw_c, vw_c, sink))
        return y, y_c
    return y, None


def hyena_filter_spectra(n, ffn_w_in, ffn_w_hid, ffn_b, sin_freq, ffn_w_out):
    f32 = jnp.float32
    t = jnp.linspace(0.0, 1.0, n, dtype=f32)[:, None]
    bands = (FILTER_EMB - 1) // 2
    w = 2.0 * math.pi * jnp.arange(n, dtype=f32)[:, None] / n
    fr = jnp.linspace(1e-4, bands - 1, bands, dtype=f32)[None, :]
    z = jnp.concatenate([t, jnp.cos(fr * w), -jnp.sin(fr * w)], -1)
    sf, fb = sin_freq.astype(f32), ffn_b.astype(f32)
    hid = jnp.sin(sf[0] * (z @ ffn_w_in.astype(f32) + fb[0]))
    hid = jnp.sin(sf[1] * (hid @ ffn_w_hid[0].astype(f32) + fb[1]))
    hid = jnp.sin(sf[2] * (hid @ ffn_w_hid[1].astype(f32) + fb[2]))
    filt = (hid @ ffn_w_out.astype(f32)).reshape(n, 2, HYENA_ORDER, D_MODEL)
    deltas = jnp.abs(jnp.linspace(math.log(DECAY_TARGET) / SLOW_DECAY_PCT, math.log(DECAY_TARGET) / FAST_DECAY_PCT, D_MODEL, dtype=f32))
    filt = filt * jnp.exp(-t * deltas)[:, None, None, :]
    fwd, bwd = filt[:, 0], filt[:, 1]
    kern = jnp.concatenate([fwd, jnp.zeros_like(fwd[:1]), jnp.flip(bwd[1:], 0)], 0)
    return jnp.fft.rfft(kern, axis=0)


def hyena_mixer(h, w_in, conv_w, conv_b, ffn_w_in, ffn_w_hid, ffn_b, sin_freq, ffn_w_out, skip, w_out):
    n = h.shape[1]
    u = h @ w_in
    up = jnp.pad(u, ((0, 0), (1, 1), (0, 0)))
    u = up[:, :-2] * conv_w[0] + up[:, 1:-1] * conv_w[1] + up[:, 2:] * conv_w[2] + conv_b
    v, x1, x2 = jnp.split(u, 3, axis=-1)
    spec = hyena_filter_spectra(n, ffn_w_in, ffn_w_hid, ffn_b, sin_freq, ffn_w_out)
    sk = skip.astype(jnp.float32)
    z = v
    for o, gate in enumerate((x1, x2)):
        zf32 = z.astype(jnp.float32)
        conv = jnp.fft.irfft(jnp.fft.rfft(zf32, n=2 * n, axis=1) * spec[None, :, o], n=2 * n, axis=1)[:, :n]
        z = gate * (conv + zf32 * sk[o]).astype(h.dtype)
    return z @ w_out


def moe_ffn(h, router_w, router_bias, w_gate, w_up, w_down):
    b, n, d = h.shape
    t_count = b * n
    hf = h.reshape(t_count, d)
    scores = jax.nn.softmax((hf @ router_w).astype(jnp.float32), axis=-1)
    sel = (scores + router_bias.astype(jnp.float32)).reshape(t_count, N_GROUPS, EXPERTS_PER_GROUP)
    group_score = lax.top_k(sel, 2)[0].sum(-1)
    grp = jnp.argmax(group_score, axis=-1)
    in_group = jnp.take_along_axis(sel, grp[:, None, None], axis=1)[:, 0]
    _, local = lax.top_k(in_group, TOP_K)
    e_idx = grp[:, None] * EXPERTS_PER_GROUP + local
    wts = jnp.take_along_axis(scores, e_idx, axis=-1)
    wts = wts / wts.sum(-1, keepdims=True)
    n_assign = t_count * TOP_K
    flat_e = e_idx.reshape(n_assign)
    flat_tok = jnp.arange(n_assign, dtype=jnp.int32) // TOP_K
    order = jnp.argsort(flat_e)
    se = flat_e[order]
    counts = jnp.bincount(flat_e, length=N_EXPERTS)
    pcounts = (counts + MOE_BLOCK - 1) // MOE_BLOCK * MOE_BLOCK
    pends = jnp.cumsum(pcounts)
    pstarts = pends - pcounts
    starts = jnp.cumsum(counts) - counts
    dest = pstarts[se] + jnp.arange(n_assign) - starts[se]
    n_blk = -(-(n_assign + N_EXPERTS * (MOE_BLOCK - 1)) // MOE_BLOCK)
    slot_tok = jnp.full((n_blk * MOE_BLOCK,), t_count, jnp.int32).at[dest].set(flat_tok[order])
    slot_w = jnp.zeros((n_blk * MOE_BLOCK,), jnp.float32).at[dest].set(wts.reshape(n_assign)[order])
    blk_e = jnp.minimum(jnp.searchsorted(pends, jnp.arange(n_blk) * MOE_BLOCK, side='right'), N_EXPERTS - 1)
    xs = jnp.concatenate([hf, jnp.zeros((1, d), hf.dtype)], 0)[slot_tok].reshape(n_blk, MOE_BLOCK, d)

    def expert_block(args):
        xb, e = args
        return (jax.nn.silu(xb @ w_gate[e]) * (xb @ w_up[e])) @ w_down[e]

    ys = lax.map(expert_block, (xs, blk_e)).reshape(n_blk * MOE_BLOCK, d)
    out = jnp.zeros((t_count + 1, d), hf.dtype).at[slot_tok].add(ys * slot_w[:, None].astype(ys.dtype))
    return out[:t_count].reshape(b, n, d)


def setup_inputs(seed: int = 0) -> dict:
    key = jax.random.key(seed)
    keys = iter(jax.random.split(key, 32))

    def nrm(shape, scale):
        return jax.random.normal(next(keys), shape, jnp.float32) * scale

    d = D_MODEL
    n_even = (DEPTH + 1) // 2
    n_odd = DEPTH // 2
    return {
        'x': nrm((BATCH, SEQ, d), 1.0),
        'c': nrm((BATCH, d), 1.0),
        'ctx': nrm((BATCH, CTX_LEN, d), 1.0),
        'c_ctx': nrm((d,), 1.0),
        'mod_w': nrm((DEPTH, d, 6 * d), 0.5 * d ** -0.5),
        'mod_b': nrm((DEPTH, 6 * d), 0.02),
        'ln_g': 1.0 + nrm((DEPTH, 2, d), 0.02),
        'ln_b': nrm((DEPTH, 2, d), 0.02),
        'attn_w_in': nrm((n_even, d, ATTN_PROJ_W), d ** -0.5),
        'attn_lambda': nrm((n_even, 4, HEAD_DIM), 0.1),
        'attn_subln_g': 1.0 + nrm((n_even, DIFF_V_DIM), 0.02),
        'attn_sink': nrm((n_even, WIN_Q_HEADS), 1.0),
        'attn_w_out': nrm((n_even, MIX_W, d), MIX_W ** -0.5 * DEEPNORM_BETA),
        'hy_w_in': nrm((n_odd, d, 3 * d), d ** -0.5),
        'hy_conv_w': nrm((n_odd, SHORT_CONV, 3 * d), SHORT_CONV ** -0.5),
        'hy_conv_b': nrm((n_odd, 3 * d), 0.02),
        'hy_ffn_w_in': nrm((n_odd, FILTER_EMB, FILTER_HID), FILTER_EMB ** -0.5),
        'hy_ffn_w_hid': nrm((n_odd, 2, FILTER_HID, FILTER_HID), FILTER_HID ** -0.5),
        'hy_ffn_b': nrm((n_odd, 3, FILTER_HID), 0.02),
        'hy_sin_freq': 1.0 + nrm((n_odd, 3, FILTER_HID), 0.02),
        'hy_ffn_w_out': nrm((n_odd, FILTER_HID, 2 * HYENA_ORDER * d), FILTER_OUT_SCALE * FILTER_HID ** -0.5),
        'hy_skip': nrm((n_odd, HYENA_ORDER, d), 1.0),
        'hy_w_out': nrm((n_odd, d, d), d ** -0.5 * DEEPNORM_BETA),
        'router_w': nrm((d, N_EXPERTS), d ** -0.5),
        'router_bias': nrm((N_EXPERTS,), 0.01),
        'exp_w_gate': nrm((DEPTH, N_EXPERTS, d, EXPERT_FF), d ** -0.5),
        'exp_w_up': nrm((DEPTH, N_EXPERTS, d, EXPERT_FF), d ** -0.5),
        'exp_w_down': nrm((DEPTH, N_EXPERTS, EXPERT_FF, d), EXPERT_FF ** -0.5 * DEEPNORM_BETA),
    }


def reference(x, c, ctx, c_ctx, mod_w, mod_b, ln_g, ln_b, attn_w_in, attn_lambda, attn_subln_g, attn_sink, attn_w_out,
              hy_w_in, hy_conv_w, hy_conv_b, hy_ffn_w_in, hy_ffn_w_hid, hy_ffn_b, hy_sin_freq, hy_ffn_w_out, hy_skip, hy_w_out,
              router_w, router_bias, exp_w_gate, exp_w_up, exp_w_down):
    n = x.shape[1]
    rows = n // GRID_W
    cos, sin = axial_rope_tables(rows)
    xc = ctx
    for i in range(DEPTH):
        is_attn = i % 2 == 0
        ctx_live = any(j % 2 == 0 for j in range(i + 1, DEPTH))
        sh1, sc1, g1, sh2, sc2, g2 = jnp.split((jax.nn.silu(c) @ mod_w[i] + mod_b[i])[:, None, :], 6, axis=-1)
        h = x * (1 + sc1) + sh1
        if is_attn or ctx_live:
            csh1, csc1, cg1, csh2, csc2, cg2 = jnp.split(jax.nn.silu(c_ctx) @ mod_w[i] + mod_b[i], 6, axis=-1)
            hc = xc * (1 + csc1) + csh1
        if is_attn:
            e = i // 2
            lam_init = 0.8 - 0.6 * math.exp(-0.3 * i)
            y, yc = attention_group_mixer(h, hc, attn_w_in[e], attn_lambda[e], attn_subln_g[e], attn_sink[e], attn_w_out[e],
                                          lam_init, cos, sin, ctx_live)
        else:
            o = i // 2
            hy = (hy_w_in[o], hy_conv_w[o], hy_conv_b[o], hy_ffn_w_in[o], hy_ffn_w_hid[o], hy_ffn_b[o], hy_sin_freq[o],
                  hy_ffn_w_out[o], hy_skip[o], hy_w_out[o])
            y = hyena_mixer(h, *hy)
            yc = hyena_mixer(hc, *hy) if ctx_live else None
        x = layer_norm(DEEPNORM_ALPHA * x + g1 * y, ln_g[i, 0], ln_b[i, 0])
        f = moe_ffn(x * (1 + sc2) + sh2, router_w, router_bias, exp_w_gate[i], exp_w_up[i], exp_w_down[i])
        x = layer_norm(DEEPNORM_ALPHA * x + g2 * f, ln_g[i, 1], ln_b[i, 1])
        if ctx_live:
            xc = layer_norm(DEEPNORM_ALPHA * xc + cg1 * yc, ln_g[i, 0], ln_b[i, 0])
            fc = moe_ffn(xc * (1 + csc2) + csh2, router_w, router_bias, exp_w_gate[i], exp_w_up[i], exp_w_down[i])
            xc = layer_norm(DEEPNORM_ALPHA * xc + cg2 * fc, ln_g[i, 1], ln_b[i, 1])
    return x
```

```cpp
#include <hip/hip_runtime.h>
#include <cstdio>
#include <cstdint>

#define LAS __attribute__((address_space(3)))
#define GAS __attribute__((address_space(1)))
typedef unsigned short bf16_t;
typedef short bf16x8 __attribute__((ext_vector_type(8)));
typedef short s16x4 __attribute__((ext_vector_type(4)));
typedef float f32x2 __attribute__((ext_vector_type(2)));
typedef float f32x4 __attribute__((ext_vector_type(4)));
typedef float f32x16 __attribute__((ext_vector_type(16)));
typedef unsigned u32x2 __attribute__((ext_vector_type(2)));
typedef unsigned u32x4 __attribute__((ext_vector_type(4)));

#ifndef PHASE_MASK
#define PHASE_MASK 0x7ffff
#endif
#ifndef MK_N_LAUNCHES
#define MK_N_LAUNCHES 1
#endif

constexpr int NB = 8, SEQ = 2048, DM = 1024, TOK = NB * SEQ, CTXL = 256, CTOK = NB * CTXL, KEYS = SEQ + CTXL;
constexpr int NEXP = 16, MAXBLK = 144, MAXROWS = MAXBLK * 256;
constexpr float LN_EPS = 1e-5f, DN_ALPHA = 1.41421356237309515f, LOG2E = 1.4426950408889634f;
constexpr float QSCALE = 0.125f * LOG2E;
constexpr int NPH = 19;

constexpr size_t MiB = 1u << 20;
constexpr size_t WS_CTL = 0, CTL_ZERO_BYTES = 64 * 1024;
constexpr size_t WS_MOD = 1 * MiB;
constexpr size_t WS_ROPE = WS_MOD + MiB / 2;
constexpr size_t WS_ROUTE = 2 * MiB;
constexpr size_t WS_WQK = 3 * MiB;
constexpr size_t WS_WV = WS_WQK + 3584 * 1024;
constexpr size_t WS_WO = 8 * MiB;
constexpr size_t WS_HIN = 10 * MiB;
constexpr size_t WS_HOUT = 16 * MiB;
constexpr size_t WS_KFB = 18 * MiB;
constexpr size_t WS_WGU = 34 * MiB;
constexpr size_t WS_WD = 162 * MiB;
constexpr size_t WS_HA = 226 * MiB;
constexpr size_t WS_XR = 258 * MiB;
constexpr size_t WS_Y = 322 * MiB;
constexpr size_t WS_R2 = 354 * MiB;
constexpr size_t WS_BIG = 432 * MiB;
constexpr size_t WS_SLOT = 528 * MiB;
constexpr size_t WS_END = 530 * MiB;
constexpr size_t R2_QA = 0, R2_QW = 16 * MiB, R2_KA = 32 * MiB, R2_VAT = 50 * MiB, R2_KW = 68 * MiB, R2_VWT = R2_KW + 4608 * 1024;
constexpr int SLOT_CAP = 16384;
constexpr int CW_CNT = 64;
constexpr int CW_Q1 = 3072;
constexpr int CW_BAR = 4096;

constexpr int RING_BYTES = 131072;
constexpr int MISC_OFF = 158720;
constexpr int GTAB_OFF = 131072;
constexpr int RBTAB_OFF = 137216;
constexpr int LDS_BYTES = 159744;

__device__ __forceinline__ unsigned f2bf(float f) { unsigned u = __builtin_bit_cast(unsigned, f); return (u + 0x7fffu + ((u >> 16) & 1u)) >> 16; }
__device__ __forceinline__ unsigned pk2(float lo, float hi) { return f2bf(lo) | (f2bf(hi) << 16); }
__device__ __forceinline__ float bf2f(unsigned b) { return __builtin_bit_cast(float, b << 16); }
__device__ __forceinline__ float bflo(unsigned w) { return __builtin_bit_cast(float, w << 16); }
__device__ __forceinline__ float bfhi(unsigned w) { return __builtin_bit_cast(float, w & 0xffff0000u); }
typedef __bf16 bf16x2_t __attribute__((ext_vector_type(2)));
__device__ __forceinline__ unsigned cvt_pk_bf16(float lo, float hi) { const f32x2 v = {lo, hi}; const bf16x2_t b = __builtin_convertvector(v, bf16x2_t); return __builtin_bit_cast(unsigned, b); }
#define LDS_WAIT() asm volatile("s_waitcnt lgkmcnt(0)" ::: "memory")
#define VM_WAIT() asm volatile("s_waitcnt vmcnt(0)" ::: "memory")
__device__ __forceinline__ float wave_sum(float v) {
#pragma unroll
    for (int o = 1; o < 64; o <<= 1) v += __shfl_xor(v, o);
    return v;
}
__device__ __forceinline__ int crow(int r, int hi) { return (r & 3) + 8 * (r >> 2) + 4 * hi; }

#define XB_TMO      128
#define XB_XCNT(j)  (256  + 64 * (j))
#define XB_XSUB(j)  (1280 + 64 * (j))
#define XB_XGEN(j)  (2304 + 64 * (j))
#define XB_TOP      3328
#define XB_TOPGEN   3392
#define XCD_BAR_WORDS 3456
#define XB_SPIN_CAP (1u << 18)
static_assert((CW_BAR + XCD_BAR_WORDS) * 4 <= (int)CTL_ZERO_BYTES, "barrier words inside the memset region");
__device__ __forceinline__ unsigned xb_ld(unsigned* p)              { return __hip_atomic_load(p, __ATOMIC_RELAXED, __HIP_MEMORY_SCOPE_AGENT); }
__device__ __forceinline__ unsigned xb_add(unsigned* p, unsigned v) { return __hip_atomic_fetch_add(p, v, __ATOMIC_RELAXED, __HIP_MEMORY_SCOPE_AGENT); }
__device__ __forceinline__ unsigned xb_xcc_id() { return (unsigned)__builtin_amdgcn_s_getreg((3 << 11) | 20) & 0xFu; }
#define XB_SPIN(cond, bar) do { unsigned _sp = 0; while (cond) { __builtin_amdgcn_s_sleep(1); \
    if ((++_sp & 255u) == 0u) { if (xb_ld(&(bar)[XB_TMO])) break; if (_sp > XB_SPIN_CAP) { atomicAdd(&(bar)[XB_TMO], 1u); break; } } } } while (0)
struct XcdBarrier { unsigned* bar; unsigned x; volatile LAS unsigned* st; };
__device__ __forceinline__ int lane_id() { return (int)__builtin_amdgcn_mbcnt_hi(~0u, __builtin_amdgcn_mbcnt_lo(~0u, 0u)); }
__device__ __forceinline__ XcdBarrier xcd_barrier_post(unsigned* bar, volatile LAS unsigned* st, int wave) {
    XcdBarrier b; b.bar = bar; b.x = xb_xcc_id(); b.st = st;
    if (wave == 0 && lane_id() == 0) (void)xb_add(&bar[XB_XCNT(b.x)], 1u);
    return b;
}
__device__ __forceinline__ void xcd_barrier_complete(unsigned* bar, unsigned x, unsigned& nloc, unsigned& nx) {
    const unsigned G = gridDim.x * gridDim.y * gridDim.z;
    unsigned sum, cnt, mine, sp = 0u;
    for (;;) {
        sum = 0u; cnt = 0u; mine = 0u;
#pragma unroll
        for (unsigned j = 0; j < 16; ++j) { const unsigned c = xb_ld(&bar[XB_XCNT(j)]); sum += c; cnt += (c > 0u) ? 1u : 0u; mine = (j == x) ? c : mine; }
        if (sum == G) break;
        __builtin_amdgcn_s_sleep(1);
        if ((++sp & 255u) == 0u) { if (xb_ld(&bar[XB_TMO])) break; if (sp > XB_SPIN_CAP) { atomicAdd(&bar[XB_TMO], 1u); break; } }
    }
    nloc = mine > 0u ? mine : 1u; nx = cnt > 0u ? cnt : 1u;
}
__device__ __forceinline__ void xcd_barrier(const XcdBarrier& b, int wave) {
    asm volatile("s_waitcnt vmcnt(0)" ::: "memory");
    __syncthreads();
    if (wave == 0 && lane_id() == 0) {
        unsigned* bar = b.bar;
        __builtin_amdgcn_s_waitcnt(0);
        unsigned nloc = b.st[0], nx = b.st[1];
        if (nloc == 0u) { xcd_barrier_complete(bar, b.x, nloc, nx); b.st[0] = nloc; b.st[1] = nx; }
        const unsigned old = xb_add(&bar[XB_XSUB(b.x)], 1u);
        const unsigned gen = old / nloc;
        if (old + 1u == (gen + 1u) * nloc) {
            __builtin_amdgcn_fence(__ATOMIC_RELEASE, "agent");
            asm volatile("s_waitcnt vmcnt(0)" ::: "memory");
            const unsigned og = xb_add(&bar[XB_TOP], 1u);
            const unsigned tg = og / nx;
            if (og + 1u == (tg + 1u) * nx) xb_add(&bar[XB_TOPGEN], 1u);
            else XB_SPIN(xb_ld(&bar[XB_TOPGEN]) == tg, bar);
            __builtin_amdgcn_fence(__ATOMIC_ACQUIRE, "agent");
            xb_add(&bar[XB_XGEN(b.x)], 1u);
            asm volatile("s_waitcnt vmcnt(0)" ::: "memory");
        } else {
            XB_SPIN(xb_ld(&bar[XB_XGEN(b.x)]) == gen, bar);
            __builtin_amdgcn_fence(__ATOMIC_ACQUIRE, "agent");
            asm volatile("s_waitcnt vmcnt(0)" ::: "memory");
        }
    }
    __syncthreads();
}

namespace pg8 {
constexpr int BM = 256, BK = 64, HALF = 128, HTB = HALF * BK * 2, STAGE_BYTES = 8 * HTB, KDIM = 1024;
constexpr size_t TSTEP = (size_t)BM * KDIM * 2;
__host__ __device__ __forceinline__ int lds_byte(int r, int c) { const int st = (r >> 4) * 2 + (c >> 5), rr = r & 15, cc = c & 31, ob = rr * 64 + cc * 2; return st * 1024 + (ob ^ (((ob >> 9) & 1) << 5)); }
__host__ __device__ __forceinline__ void stage_rc(int b, int& R, int& C) { const int st = b / 1024, sb = b % 1024, swz = sb ^ (((sb >> 9) & 1) << 5); R = (st >> 1) * 16 + swz / 64; C = (st & 1) * 32 + (swz % 64) / 2; }
__host__ __device__ __forceinline__ int perm32(int rho) { const int n = rho >> 4, i = rho & 15; return 8 * (i >> 2) + 4 * n + (i & 3); }
struct Unit { const char* A; const char* B; int r0, c0, kind, aux; };
template <class Epi, class Sched, bool GATHER = false>
__device__ __forceinline__ void gemm_phase(LAS unsigned char* lds, const Sched& S, const Epi& E, const int tid, const LAS unsigned* gtab = nullptr) {
    const int wid = __builtin_amdgcn_readfirstlane(tid >> 6), lane = tid & 63, wr = wid >> 2, wc = wid & 3, fr = lane & 15, fq = lane >> 4;
    constexpr int K = KDIM, nt = K / BK;
    unsigned voffA[2], voffB[2]; int gR[2]; unsigned gC[2];
    unsigned voA_hi[2], vnA_lo[2], vnA_hi[2];
#pragma unroll
    for (int i = 0; i < 2; ++i) { int R, C; stage_rc(tid * 16 + i * 8192, R, C); const int Rb = (R & ~31) + perm32(R & 31);
        voffA[i] = (unsigned)(R * K + C) * 2u; voffB[i] = (unsigned)(Rb * K + C) * 2u; gR[i] = R; gC[i] = (unsigned)C * 2u; voA_hi[i] = 0u; vnA_lo[i] = 0u; vnA_hi[i] = 0u; }
    const size_t kstep = (size_t)(BK * 2);
    const size_t hstep = (size_t)HALF * K * 2;
    const unsigned ldsw = (unsigned)wid * 1024u;
    const int aoff = lds_byte(wr * 64 + fr, fq * 8), boff = lds_byte(wc * 32 + fr, fq * 8);
#define PG8_SA(b, h) (((b) * 2 + (h)) * HTB)
#define PG8_SB(b, h) ((4 + (b) * 2 + (h)) * HTB)
#define PG8_STAGE(bufoff, gbase, voff) do { _Pragma("unroll") for (int _i = 0; _i < 2; ++_i) \
        __builtin_amdgcn_global_load_lds((const GAS unsigned*)((const char*)(gbase) + (voff)[_i]), (LAS unsigned*)(lds + (bufoff) + ldsw + _i * 8192), 16, 0, 0); } while (0)
#define PG8_LDA(dst, b, h) do { _Pragma("unroll") for (int m = 0; m < 4; ++m) _Pragma("unroll") for (int k = 0; k < 2; ++k) dst[m][k] = *(const LAS bf16x8*)(lds + PG8_SA(b, h) + aoff + m * 2048 + k * 1024); } while (0)
#define PG8_LDB(dst, b, h) do { _Pragma("unroll") for (int n = 0; n < 2; ++n) _Pragma("unroll") for (int k = 0; k < 2; ++k) dst[n][k] = *(const LAS bf16x8*)(lds + PG8_SB(b, h) + boff + n * 2048 + k * 1024); } while (0)
#define PG8_MMA(ai, bj, At, Bt) do { __builtin_amdgcn_s_setprio(1); _Pragma("unroll") for (int m = 0; m < 4; ++m) _Pragma("unroll") for (int n = 0; n < 2; ++n) _Pragma("unroll") for (int k = 0; k < 2; ++k) \
        acc[ai][bj][m][n] = __builtin_amdgcn_mfma_f32_16x16x32_bf16(Bt[n][k], At[m][k], acc[ai][bj][m][n], 0, 0, 0); __builtin_amdgcn_s_setprio(0); } while (0)
#define PG8_WAIT_V(n) asm volatile("s_waitcnt vmcnt(" #n ")" ::: "memory")
#define PG8_WAIT_L(n) asm volatile("s_waitcnt lgkmcnt(" #n ")" ::: "memory")
#define PG8_BAR __builtin_amdgcn_s_barrier()
#define PG8_SCHED __builtin_amdgcn_sched_barrier(0)
    Unit cur, nxt; int ui = 0;
    if (!S.next(0, cur)) return;
    f32x4 acc[2][2][4][2];
#pragma unroll
    for (int a = 0; a < 2; ++a)
#pragma unroll
        for (int b = 0; b < 2; ++b)
#pragma unroll
            for (int m = 0; m < 4; ++m)
#pragma unroll
                for (int n = 0; n < 2; ++n) acc[a][b][m][n] = (f32x4){0.f, 0.f, 0.f, 0.f};
    bf16x8 At[4][2], B0[2][2], B1[2][2];
    const char* cA = cur.A; const char* cB = cur.B;
    if constexpr (GATHER) {
#pragma unroll
        for (int i = 0; i < 2; ++i) { voffA[i] = gtab[gR[i]] + gC[i]; voA_hi[i] = gtab[128 + gR[i]] + gC[i]; }
    }
#define PG8_STAGE_HI(bufoff, gbase, cur_) do { if constexpr (GATHER) { unsigned vs_[2]; vs_[0] = (cur_) ? voA_hi[0] : vnA_hi[0]; vs_[1] = (cur_) ? voA_hi[1] : vnA_hi[1]; PG8_STAGE(bufoff, gbase, vs_); } else PG8_STAGE(bufoff, (gbase) + hstep, voffA); } while (0)
#define PG8_STAGE_LO(bufoff, gbase, cur_) do { if constexpr (GATHER) { unsigned vs_[2]; vs_[0] = (cur_) ? voffA[0] : vnA_lo[0]; vs_[1] = (cur_) ? voffA[1] : vnA_lo[1]; PG8_STAGE(bufoff, gbase, vs_); } else PG8_STAGE(bufoff, gbase, voffA); } while (0)
    PG8_STAGE(PG8_SB(0, 0), cB, voffB); PG8_STAGE(PG8_SB(0, 1), cB + hstep, voffB); PG8_STAGE(PG8_SA(0, 0), cA, voffA); PG8_STAGE_HI(PG8_SA(0, 1), cA, true);
    if (wr == 1) PG8_BAR;
    PG8_WAIT_V(2); PG8_BAR;
    PG8_STAGE(PG8_SB(1, 0), cB + kstep, voffB); PG8_STAGE(PG8_SA(1, 0), cA + kstep, voffA); PG8_STAGE(PG8_SB(1, 1), cB + hstep + kstep, voffB);
    PG8_WAIT_V(6); PG8_BAR;
    for (;;) {
        const bool has_next = S.next(ui + 1, nxt);
        const char* nA = has_next ? nxt.A : cA; const char* nB = has_next ? nxt.B : cB;
        if constexpr (GATHER) {
#pragma unroll
            for (int i = 0; i < 2; ++i) { vnA_lo[i] = has_next ? gtab[(ui + 1) * 256 + gR[i]] + gC[i] : voffA[i]; vnA_hi[i] = has_next ? gtab[(ui + 1) * 256 + 128 + gR[i]] + gC[i] : voA_hi[i]; }
        }
        for (int t = 0; t < nt; t += 2) {
            const bool last = (t == nt - 2);
            const char* a1 = cA + (size_t)(t + 1) * kstep;
            const char* a2 = last ? nA : cA + (size_t)(t + 2) * kstep; const char* b2 = last ? nB : cB + (size_t)(t + 2) * kstep;
            const char* a3 = a2 + kstep; const char* b3 = b2 + kstep;
            PG8_LDB(B0, 0, 0); PG8_LDB(B1, 0, 1); PG8_SCHED; PG8_LDA(At, 0, 0); PG8_STAGE_HI(PG8_SA(1, 1), a1, true);
            PG8_WAIT_V(8); PG8_WAIT_L(0); PG8_BAR; PG8_MMA(0, 0, At, B0); PG8_MMA(0, 1, At, B1); PG8_BAR; PG8_SCHED;
            PG8_LDA(At, 0, 1); PG8_STAGE(PG8_SB(0, 0), b2, voffB); PG8_STAGE(PG8_SB(0, 1), b2 + hstep, voffB); PG8_STAGE_LO(PG8_SA(0, 0), a2, !last);
            PG8_WAIT_V(8); PG8_WAIT_L(0); PG8_BAR; PG8_MMA(1, 0, At, B0); PG8_MMA(1, 1, At, B1); PG8_BAR; PG8_SCHED;
            PG8_LDB(B0, 1, 0); PG8_LDB(B1, 1, 1); PG8_SCHED; PG8_LDA(At, 1, 0); PG8_STAGE_HI(PG8_SA(0, 1), a2, !last);
            PG8_WAIT_V(8); PG8_WAIT_L(0); PG8_BAR; PG8_MMA(0, 0, At, B0); PG8_MMA(0, 1, At, B1); PG8_BAR; PG8_SCHED;
            PG8_LDA(At, 1, 1); PG8_STAGE(PG8_SB(1, 0), b3, voffB); PG8_STAGE(PG8_SB(1, 1), b3 + hstep, voffB); PG8_STAGE_LO(PG8_SA(1, 0), a3, !last);
            PG8_WAIT_V(8); PG8_WAIT_L(0); PG8_BAR; PG8_MMA(1, 0, At, B0); PG8_MMA(1, 1, At, B1); PG8_BAR; PG8_SCHED;
        }
        if (wr == 0) PG8_BAR;
        E(acc, cur, wr, wc, fr, fq);
        if (!has_next) break;
#pragma unroll
        for (int a = 0; a < 2; ++a)
#pragma unroll
            for (int b = 0; b < 2; ++b)
#pragma unroll
                for (int m = 0; m < 4; ++m)
#pragma unroll
                    for (int n = 0; n < 2; ++n) acc[a][b][m][n] = (f32x4){0.f, 0.f, 0.f, 0.f};
        cur = nxt; cA = nA; cB = nB; ++ui;
        if constexpr (GATHER) {
#pragma unroll
            for (int i = 0; i < 2; ++i) { voffA[i] = vnA_lo[i]; voA_hi[i] = vnA_hi[i]; }
        }
        if (wr == 1) PG8_BAR;
    }
    PG8_WAIT_V(0);
    PG8_BAR;
#undef PG8_SA
#undef PG8_SB
#undef PG8_STAGE
#undef PG8_STAGE_HI
#undef PG8_STAGE_LO
#undef PG8_LDA
#undef PG8_LDB
#undef PG8_MMA
#undef PG8_WAIT_V
#undef PG8_WAIT_L
#undef PG8_BAR
#undef PG8_SCHED
}

struct Seg { const char* A; const char* B; int nA, nB, fastA, kind; };
struct SegSched {
    Seg s[4]; int nseg, G, c;
    __device__ __forceinline__ bool next(int i, Unit& u) const {
        int L = i * G + c;
#pragma unroll
        for (int k = 0; k < 4; ++k) {
            if (k < nseg) {
                const int n = s[k].nA * s[k].nB;
                if (L < n) {
                    int ia, ib;
                    if (s[k].fastA) { ia = L % s[k].nA; ib = L / s[k].nA; } else { ib = L % s[k].nB; ia = L / s[k].nB; }
                    u.A = s[k].A + (size_t)ia * TSTEP; u.B = s[k].B + (size_t)ib * TSTEP; u.r0 = ia; u.c0 = ib; u.kind = s[k].kind; u.aux = 0; return true;
                }
                L -= n;
            }
        }
        return false;
    }
};
struct MoeSched {
    const char* A; const char* B; const LAS int* rbtab; int nct, G, c; bool gatherA;
    __device__ __forceinline__ bool next(int i, Unit& u) const {
        const int L = i * G + c; const int rb = L / nct, ct = L - rb * nct;
        if (rb >= MAXBLK) return false;
        const int e = rbtab[rb];
        if (e < 0) return false;
        u.A = gatherA ? A : A + (size_t)rb * TSTEP; u.B = B + (size_t)(e * nct + ct) * TSTEP; u.r0 = rb; u.c0 = e * nct + ct; u.kind = 0; u.aux = ct; return true;
    }
};
}

struct WsPtrs {
    bf16_t *QA, *QW, *KA, *VAT, *KW, *VWT;
    const float* rope;
};
struct EpiProj {
    WsPtrs P;
    __device__ __forceinline__ void operator()(const f32x4 (&acc)[2][2][4][2], const pg8::Unit& u, int wr, int wc, int fr, int fq) const {
        if (u.kind == 0 || u.kind == 1) {
#pragma unroll
            for (int bj = 0; bj < 2; ++bj) {
                const int gcol = (u.kind == 0 ? 0 : 1024) + u.c0 * 256 + bj * 128 + wc * 32 + fq * 8;
                if (gcol >= 1664) continue;
                const int p = gcol & 63;
#pragma unroll
                for (int ai = 0; ai < 2; ++ai)
#pragma unroll
                    for (int m = 0; m < 4; ++m) {
                        const int row = u.r0 * 256 + ai * 128 + wr * 64 + m * 16 + fr;
                        int b, t;
                        if (u.kind == 0) { b = row >> 11; t = row & 2047; } else { b = row >> 8; t = 2048 + (row & 255); }
                        f32x4 v0 = acc[ai][bj][m][0], v1 = acc[ai][bj][m][1];
                        if (u.kind == 0) {
                            const f32x4* rp = (const f32x4*)(P.rope + ((size_t)t * 32 + (p >> 1)) * 2);
                            const f32x4 c0 = rp[0], c1 = rp[1];
                            f32x4 o0, o1;
                            o0[0] = v0[0] * c0[0] - v0[1] * c0[1]; o0[1] = v0[1] * c0[0] + v0[0] * c0[1];
                            o0[2] = v0[2] * c0[2] - v0[3] * c0[3]; o0[3] = v0[3] * c0[2] + v0[2] * c0[3];
                            o1[0] = v1[0] * c1[0] - v1[1] * c1[1]; o1[1] = v1[1] * c1[0] + v1[0] * c1[1];
                            o1[2] = v1[2] * c1[2] - v1[3] * c1[3]; o1[3] = v1[3] * c1[2] + v1[2] * c1[3];
                            v0 = o0; v1 = o1;
                            if (gcol < 1024) { v0 = v0 * QSCALE; v1 = v1 * QSCALE; }
                        }
                        bf16_t* dst;
                        if (gcol < 512)       dst = P.QA + ((size_t)((b * 8 + (gcol >> 6)) * 2048 + t)) * 64 + p;
                        else if (gcol < 1024) dst = P.QW + ((size_t)((b * 8 + ((gcol - 512) >> 6)) * 2048 + t)) * 64 + p;
                        else if (gcol < 1536) dst = P.KA + ((size_t)((b * 8 + ((gcol - 1024) >> 6)) * KEYS + t)) * 64 + p;
                        else                  dst = P.KW + ((size_t)((b * 2 + ((gcol - 1536) >> 6)) * KEYS + t)) * 64 + p;
                        u32x4 w; w.x = cvt_pk_bf16(v0[0], v0[1]); w.y = cvt_pk_bf16(v0[2], v0[3]); w.z = cvt_pk_bf16(v1[0], v1[1]); w.w = cvt_pk_bf16(v1[2], v1[3]);
                        *(u32x4*)dst = w;
                    }
            }
        } else {
#pragma unroll
            for (int ai = 0; ai < 2; ++ai)
#pragma unroll
                for (int m = 0; m < 4; ++m) {
                    const int ch = u.r0 * 256 + ai * 128 + wr * 64 + m * 16 + fr;
                    if (ch >= 640) continue;
#pragma unroll
                    for (int bj = 0; bj < 2; ++bj) {
                        const int tk = u.c0 * 256 + bj * 128 + wc * 32 + fq * 8;
                        int b, t;
                        if (u.kind == 2) { b = tk >> 11; t = tk & 2047; } else { b = tk >> 8; t = 2048 + (tk & 255); }
                        bf16_t* dst;
                        if (ch < 512) dst = P.VAT + ((size_t)(b * 512 + ch)) * KEYS + (t & ~15);
                        else          dst = P.VWT + ((size_t)(b * 128 + (ch - 512))) * KEYS + (t & ~15);
                        const f32x4 v0 = acc[ai][bj][m][0], v1 = acc[ai][bj][m][1];
                        u32x2 wa, wb; wa.x = cvt_pk_bf16(v0[0], v0[1]); wa.y = cvt_pk_bf16(v0[2], v0[3]); wb.x = cvt_pk_bf16(v1[0], v1[1]); wb.y = cvt_pk_bf16(v1[2], v1[3]);
                        const int hi8 = (t >> 3) & 1;
                        *(u32x2*)(dst + 4 * hi8) = wa; *(u32x2*)(dst + 8 + 4 * hi8) = wb;
                    }
                }
        }
    }
};
struct EpiRowBf16 {
    bf16_t* O; int ld;
    __device__ __forceinline__ void operator()(const f32x4 (&acc)[2][2][4][2], const pg8::Unit& u, int wr, int wc, int fr, int fq) const {
#pragma unroll
        for (int ai = 0; ai < 2; ++ai)
#pragma unroll
            for (int m = 0; m < 4; ++m) {
                bf16_t* rowp = O + (size_t)(u.r0 * 256 + ai * 128 + wr * 64 + m * 16 + fr) * ld + u.c0 * 256 + wc * 32 + fq * 8;
#pragma unroll
                for (int bj = 0; bj < 2; ++bj) {
                    const f32x4 v0 = acc[ai][bj][m][0], v1 = acc[ai][bj][m][1];
                    u32x4 w; w.x = cvt_pk_bf16(v0[0], v0[1]); w.y = cvt_pk_bf16(v0[2], v0[3]); w.z = cvt_pk_bf16(v1[0], v1[1]); w.w = cvt_pk_bf16(v1[2], v1[3]);
                    *(u32x4*)(rowp + bj * 128) = w;
                }
            }
    }
};
struct EpiGateUp {
    bf16_t* ACT;
    __device__ __forceinline__ void operator()(const f32x4 (&acc)[2][2][4][2], const pg8::Unit& u, int wr, int wc, int fr, int fq) const {
#pragma unroll
        for (int ai = 0; ai < 2; ++ai)
#pragma unroll
            for (int m = 0; m < 4; ++m) {
                bf16_t* dst = ACT + (size_t)(u.r0 * 256 + ai * 128 + wr * 64 + m * 16 + fr) * 1024 + u.aux * 128 + wc * 32 + fq * 8;
                float o[8];
#pragma unroll
                for (int n = 0; n < 2; ++n)
#pragma unroll
                    for (int j = 0; j < 4; ++j) { const float g = acc[ai][0][m][n][j], up = acc[ai][1][m][n][j]; o[n * 4 + j] = g * __builtin_amdgcn_rcpf(1.0f + __expf(-g)) * up; }
                u32x4 w; w.x = cvt_pk_bf16(o[0], o[1]); w.y = cvt_pk_bf16(o[2], o[3]); w.z = cvt_pk_bf16(o[4], o[5]); w.w = cvt_pk_bf16(o[6], o[7]);
                *(u32x4*)dst = w;
            }
    }
};
struct EpiDown {
    bf16_t* F2; const int* slot_tok; const float* slot_w; const LAS int* rbloc; const LAS int* ecnt;
    __device__ __forceinline__ void operator()(const f32x4 (&acc)[2][2][4][2], const pg8::Unit& u, int wr, int wc, int fr, int fq) const {
        const int e = u.c0 >> 2, cnt = ecnt[e], sbase = rbloc[u.r0] * 256;
#pragma unroll
        for (int ai = 0; ai < 2; ++ai)
#pragma unroll
            for (int m = 0; m < 4; ++m) {
                const int slot = sbase + ai * 128 + wr * 64 + m * 16 + fr;
                if (slot >= cnt) continue;
                const int st = slot_tok[e * SLOT_CAP + slot]; const float wt = slot_w[e * SLOT_CAP + slot];
                bf16_t* rowp = F2 + (size_t)st * 1024 + u.aux * 256 + wc * 32 + fq * 8;
#pragma unroll
                for (int bj = 0; bj < 2; ++bj) {
                    const f32x4 v0 = acc[ai][bj][m][0] * wt, v1 = acc[ai][bj][m][1] * wt;
                    u32x4 w; w.x = cvt_pk_bf16(v0[0], v0[1]); w.y = cvt_pk_bf16(v0[2], v0[3]); w.z = cvt_pk_bf16(v1[0], v1[1]); w.w = cvt_pk_bf16(v1[2], v1[3]);
                    *(u32x4*)(rowp + bj * 128) = w;
                }
            }
    }
};

#ifndef ATT_SERIAL
#define ATT_SERIAL 0
#endif
#ifndef ATT_STAGGER
#define ATT_STAGGER 0
#endif
__device__ __forceinline__ float max3f(float a, float b, float c) { float r; asm("v_max3_f32 %0, %1, %2, %3" : "=v"(r) : "v"(a), "v"(b), "v"(c)); return r; }
template <int DVT>
__device__ __forceinline__ void softmax_step(f32x16& S, float& m, float& l, f32x16 (&O)[DVT], bf16x8& pb0, bf16x8& pb1) {
    asm volatile("s_nop 15\n\ts_nop 7" : "+v"(S));
    float ta = max3f(S[0], S[1], S[2]), tb = max3f(S[3], S[4], S[5]);
    ta = max3f(ta, S[6], S[7]); tb = max3f(tb, S[8], S[9]); ta = max3f(ta, S[10], S[11]); tb = max3f(tb, S[12], S[13]); ta = max3f(ta, S[14], S[15]);
    const float tm = max3f(ta, tb, m);
    const float mn = max3f(tm, __shfl_xor(tm, 32), tm);
    const float alpha = __builtin_amdgcn_exp2f(m - mn);
    if (__any(alpha != 1.0f)) {
#pragma unroll
        for (int d = 0; d < DVT; ++d) O[d] = O[d] * alpha;
    }
    float s = 0.f;
#pragma unroll
    for (int r = 0; r < 16; ++r) { S[r] = __builtin_amdgcn_exp2f(S[r] - mn); s += S[r]; }
    l = l * alpha + s; m = mn;
    u32x4 w0, w1;
    w0.x = cvt_pk_bf16(S[0], S[1]); w0.y = cvt_pk_bf16(S[2], S[3]); w0.z = cvt_pk_bf16(S[4], S[5]); w0.w = cvt_pk_bf16(S[6], S[7]);
    w1.x = cvt_pk_bf16(S[8], S[9]); w1.y = cvt_pk_bf16(S[10], S[11]); w1.z = cvt_pk_bf16(S[12], S[13]); w1.w = cvt_pk_bf16(S[14], S[15]);
    pb0 = __builtin_bit_cast(bf16x8, w0); pb1 = __builtin_bit_cast(bf16x8, w1);
}
__device__ __forceinline__ void dma_rows8(const bf16_t* src, size_t pitch, LAS unsigned char* img, int row0, int lane) {
    const int r = row0 + (lane >> 3), c = (lane & 7) ^ ((r >> 1) & 7);
    __builtin_amdgcn_global_load_lds((const GAS unsigned*)(src + (size_t)(lane >> 3) * pitch + c * 8), (LAS unsigned*)(img + row0 * 128), 16, 0, 0);
}
#define ATT_WAIT_BAR() do { asm volatile("s_waitcnt vmcnt(0) lgkmcnt(0)" ::: "memory"); __builtin_amdgcn_s_barrier(); asm volatile("" ::: "memory"); } while (0)

__device__ __forceinline__ void diff_attn_block(LAS unsigned char* lds, const bf16_t* QA, const bf16_t* KA, const bf16_t* VAT, bf16_t* CAT, const float* subln_g, float lam, int b, int h, int qb, int wave, int lane) {
    const int r32 = lane & 31, hi = lane >> 5, q0 = qb * 256 + wave * 32;
    const bf16_t* q0p = QA + ((size_t)((b * 4 + h) * 2) * SEQ + q0 + r32) * 64 + 8 * hi;
    const bf16_t* q1p = q0p + (size_t)SEQ * 64;
    LAS unsigned char* qlds = lds + 65536 + wave * 8192 + lane * 16;
#pragma unroll
    for (int ds = 0; ds < 4; ++ds) { *(LAS bf16x8*)(qlds + ds * 1024) = *(const bf16x8*)(q0p + 16 * ds); *(LAS bf16x8*)(qlds + 4096 + ds * 1024) = *(const bf16x8*)(q1p + 16 * ds); }
    const bf16_t* k0g = KA + (size_t)((b * 4 + h) * 2) * KEYS * 64 + (size_t)(8 * wave) * 64;
    const bf16_t* vtg = VAT + ((size_t)((b * 4 + h) * 128) + 16 * wave) * KEYS;
    const int fx = ((r32 >> 1) & 7) << 4;
    const int koff = r32 * 128, voff = 16384 + r32 * 128;
#define DIFF_STAGE(t, buf) do { LAS unsigned char* sb_ = lds + (buf) * 32768; const size_t k_ = (size_t)(t) * 64; \
        dma_rows8(k0g + k_ * 64, 64, sb_, 8 * wave, lane); dma_rows8(k0g + (size_t)KEYS * 64 + k_ * 64, 64, sb_ + 8192, 8 * wave, lane); \
        dma_rows8(vtg + k_, KEYS, sb_ + 16384, 16 * wave, lane); dma_rows8(vtg + (size_t)8 * KEYS + k_, KEYS, sb_ + 16384, 16 * wave + 8, lane); } while (0)
    f32x16 O0[4], O1[4];
#pragma unroll
    for (int d = 0; d < 4; ++d)
#pragma unroll
        for (int r = 0; r < 16; ++r) { O0[d][r] = 0.f; O1[d][r] = 0.f; }
    float m0 = -1e30f, m1 = -1e30f, l0 = 0.f, l1 = 0.f;
    DIFF_STAGE(0, 0);
    constexpr int NT = KEYS / 64;
    for (int t = 0; t < NT; ++t) {
        ATT_WAIT_BAR();
#if !ATT_SERIAL
        if (t + 1 < NT) DIFF_STAGE(t + 1, (t + 1) & 1);
#endif
        const LAS unsigned char* sb = lds + (t & 1) * 32768;
#if ATT_STAGGER
        if (wave >= 4) __builtin_amdgcn_s_sleep(ATT_STAGGER);
#endif
#pragma unroll 1
        for (int st = 0; st < 2; ++st) {
            bf16x8 pa0, pa1, pb0, pb1;
            f32x16 S0 = {0.f, 0.f, 0.f, 0.f, 0.f, 0.f, 0.f, 0.f, 0.f, 0.f, 0.f, 0.f, 0.f, 0.f, 0.f, 0.f}, S1 = S0;
            const LAS unsigned char* kb_ = sb + koff + st * 4096; const LAS unsigned char* vb_ = sb + voff;
#define KQ_LOAD(ds_, k0, q0, k1, q1) do { k0 = *(const LAS bf16x8*)(kb_ + (((2 * (ds_) + hi) << 4) ^ fx)); q0 = *(const LAS bf16x8*)(qlds + (ds_) * 1024); \
                k1 = *(const LAS bf16x8*)(kb_ + 8192 + (((2 * (ds_) + hi) << 4) ^ fx)); q1 = *(const LAS bf16x8*)(qlds + 4096 + (ds_) * 1024); __builtin_amdgcn_sched_barrier(0); } while (0)
#define V_LOAD(d_, v0, v1) do { v0 = *(const LAS bf16x8*)(vb_ + (d_) * 4096 + (((4 * st + hi) << 4) ^ fx)); v1 = *(const LAS bf16x8*)(vb_ + (d_) * 4096 + (((4 * st + 2 + hi) << 4) ^ fx)); __builtin_amdgcn_sched_barrier(0); } while (0)
            {
                bf16x8 ak0, aq0, ak1, aq1, bk0, bq0, bk1, bq1;
                KQ_LOAD(0, ak0, aq0, ak1, aq1);
                KQ_LOAD(1, bk0, bq0, bk1, bq1);
                S0 = __builtin_amdgcn_mfma_f32_32x32x16_bf16(ak0, aq0, S0, 0, 0, 0); S1 = __builtin_amdgcn_mfma_f32_32x32x16_bf16(ak1, aq1, S1, 0, 0, 0);
            __builtin_amdgcn_sched_barrier(0);
                KQ_LOAD(2, ak0, aq0, ak1, aq1);
                S0 = __builtin_amdgcn_mfma_f32_32x32x16_bf16(bk0, bq0, S0, 0, 0, 0); S1 = __builtin_amdgcn_mfma_f32_32x32x16_bf16(bk1, bq1, S1, 0, 0, 0);
            __builtin_amdgcn_sched_barrier(0);
                KQ_LOAD(3, bk0, bq0, bk1, bq1);
                S0 = __builtin_amdgcn_mfma_f32_32x32x16_bf16(ak0, aq0, S0, 0, 0, 0); S1 = __builtin_amdgcn_mfma_f32_32x32x16_bf16(ak1, aq1, S1, 0, 0, 0);
            __builtin_amdgcn_sched_barrier(0);
                S0 = __builtin_amdgcn_mfma_f32_32x32x16_bf16(bk0, bq0, S0, 0, 0, 0); S1 = __builtin_amdgcn_mfma_f32_32x32x16_bf16(bk1, bq1, S1, 0, 0, 0);
            __builtin_amdgcn_sched_barrier(0);
            }
            bf16x8 va0, va1, vb0, vb1;
            V_LOAD(0, va0, va1);
            softmax_step<4>(S0, m0, l0, O0, pa0, pa1);
            V_LOAD(1, vb0, vb1);
            O0[0] = __builtin_amdgcn_mfma_f32_32x32x16_bf16(va0, pa0, O0[0], 0, 0, 0); O0[0] = __builtin_amdgcn_mfma_f32_32x32x16_bf16(va1, pa1, O0[0], 0, 0, 0);
            __builtin_amdgcn_sched_barrier(0);
            V_LOAD(2, va0, va1);
            O0[1] = __builtin_amdgcn_mfma_f32_32x32x16_bf16(vb0, pa0, O0[1], 0, 0, 0); O0[1] = __builtin_amdgcn_mfma_f32_32x32x16_bf16(vb1, pa1, O0[1], 0, 0, 0);
            __builtin_amdgcn_sched_barrier(0);
            V_LOAD(3, vb0, vb1);
            O0[2] = __builtin_amdgcn_mfma_f32_32x32x16_bf16(va0, pa0, O0[2], 0, 0, 0); O0[2] = __builtin_amdgcn_mfma_f32_32x32x16_bf16(va1, pa1, O0[2], 0, 0, 0);
            __builtin_amdgcn_sched_barrier(0);
            V_LOAD(0, va0, va1);
            O0[3] = __builtin_amdgcn_mfma_f32_32x32x16_bf16(vb0, pa0, O0[3], 0, 0, 0); O0[3] = __builtin_amdgcn_mfma_f32_32x32x16_bf16(vb1, pa1, O0[3], 0, 0, 0);
            __builtin_amdgcn_sched_barrier(0);
            softmax_step<4>(S1, m1, l1, O1, pb0, pb1);
            V_LOAD(1, vb0, vb1);
            O1[0] = __builtin_amdgcn_mfma_f32_32x32x16_bf16(va0, pb0, O1[0], 0, 0, 0); O1[0] = __builtin_amdgcn_mfma_f32_32x32x16_bf16(va1, pb1, O1[0], 0, 0, 0);
            __builtin_amdgcn_sched_barrier(0);
            V_LOAD(2, va0, va1);
            O1[1] = __builtin_amdgcn_mfma_f32_32x32x16_bf16(vb0, pb0, O1[1], 0, 0, 0); O1[1] = __builtin_amdgcn_mfma_f32_32x32x16_bf16(vb1, pb1, O1[1], 0, 0, 0);
            __builtin_amdgcn_sched_barrier(0);
            V_LOAD(3, vb0, vb1);
            O1[2] = __builtin_amdgcn_mfma_f32_32x32x16_bf16(va0, pb0, O1[2], 0, 0, 0); O1[2] = __builtin_amdgcn_mfma_f32_32x32x16_bf16(va1, pb1, O1[2], 0, 0, 0);
            __builtin_amdgcn_sched_barrier(0);
            O1[3] = __builtin_amdgcn_mfma_f32_32x32x16_bf16(vb0, pb0, O1[3], 0, 0, 0); O1[3] = __builtin_amdgcn_mfma_f32_32x32x16_bf16(vb1, pb1, O1[3], 0, 0, 0);
            __builtin_amdgcn_sched_barrier(0);
#undef KQ_LOAD
#undef V_LOAD
        }
#if ATT_SERIAL
        ATT_WAIT_BAR();
        if (t + 1 < NT) DIFF_STAGE(t + 1, (t + 1) & 1);
#endif
    }
#undef DIFF_STAGE
    l0 += __shfl_xor(l0, 32); l1 += __shfl_xor(l1, 32);
    const float i0 = 1.0f / l0, i1 = lam / l1;
    float ss = 0.f;
#pragma unroll
    for (int d = 0; d < 4; ++d)
#pragma unroll
        for (int r = 0; r < 16; ++r) { const float o = O0[d][r] * i0 - O1[d][r] * i1; O0[d][r] = o; ss += o * o; }
    ss += __shfl_xor(ss, 32);
    const float rn = 0.8f / sqrtf(ss * (1.0f / 128.0f) + LN_EPS);
    bf16_t* orow = CAT + (size_t)(b * SEQ + q0 + r32) * DM + h * 128 + 4 * hi;
#pragma unroll
    for (int d = 0; d < 4; ++d)
#pragma unroll
        for (int g = 0; g < 4; ++g) {
            const int e = d * 32 + 8 * g;
            const f32x4 gg = *(const f32x4*)(subln_g + e + 4 * hi);
            u32x2 w; w.x = cvt_pk_bf16(O0[d][4 * g] * rn * gg[0], O0[d][4 * g + 1] * rn * gg[1]); w.y = cvt_pk_bf16(O0[d][4 * g + 2] * rn * gg[2], O0[d][4 * g + 3] * rn * gg[3]);
            *(u32x2*)(orow + e) = w;
        }
    ATT_WAIT_BAR();
}

__device__ __forceinline__ void win_attn_block(LAS unsigned char* lds, const bf16_t* QW, const bf16_t* KW, const bf16_t* VWT, bf16_t* CAT, const float* sink, int b, int hkv, int qblk, int wave, int lane) {
    const int r32 = lane & 31, hi = lane >> 5, hq = hkv * 4 + (wave >> 1), q0 = qblk * 64 + (wave & 1) * 32;
    const bf16_t* qp = QW + ((size_t)(b * 8 + hq) * SEQ + q0 + r32) * 64 + 8 * hi;
    bf16x8 qf[4];
#pragma unroll
    for (int ds = 0; ds < 4; ++ds) qf[ds] = *(const bf16x8*)(qp + 16 * ds);
    const bf16_t* kg = KW + (size_t)(b * 2 + hkv) * KEYS * 64 + (size_t)(8 * wave) * 64;
    const bf16_t* vtg = VWT + ((size_t)((b * 2 + hkv) * 64) + 8 * wave) * KEYS;
    const int fx = ((r32 >> 1) & 7) << 4;
    const int koff = r32 * 128, voff = 8192 + r32 * 128;
    const int jl0 = qblk - 2, jl = jl0 > 0 ? jl0 : 0, jh = (qblk + 2 < 31) ? qblk + 2 : 31, nloc = jh - jl + 1, NT = nloc + 4;
#define WIN_KEY0(i) (((i) < nloc) ? (jl + (i)) * 64 : SEQ + ((i) - nloc) * 64)
#define WIN_STAGE(i, buf) do { LAS unsigned char* sb_ = lds + (buf) * 16384; const size_t k_ = (size_t)WIN_KEY0(i); \
        dma_rows8(kg + k_ * 64, 64, sb_, 8 * wave, lane); dma_rows8(vtg + k_, KEYS, sb_ + 8192, 8 * wave, lane); } while (0)
    f32x16 O[2];
#pragma unroll
    for (int d = 0; d < 2; ++d)
#pragma unroll
        for (int r = 0; r < 16; ++r) O[d][r] = 0.f;
    float m = sink[hq] * LOG2E, l = (hi == 0) ? 1.0f : 0.f;
    const int tq = q0 + r32;
    WIN_STAGE(0, 0);
    for (int i = 0; i < NT; ++i) {
        ATT_WAIT_BAR();
#if !ATT_SERIAL
        if (i + 1 < NT) WIN_STAGE(i + 1, (i + 1) & 1);
#endif
        const LAS unsigned char* sb = lds + (i & 1) * 16384;
        const bool local = i < nloc; const int key0 = WIN_KEY0(i);
#pragma unroll
        for (int st = 0; st < 2; ++st) {
            const int kb = key0 + 32 * st;
            if (local && (kb > q0 + 31 + 128 || kb + 31 < q0 - 128)) continue;
            f32x16 S = {0.f, 0.f, 0.f, 0.f, 0.f, 0.f, 0.f, 0.f, 0.f, 0.f, 0.f, 0.f, 0.f, 0.f, 0.f, 0.f};
#pragma unroll
            for (int ds = 0; ds < 4; ++ds) S = __builtin_amdgcn_mfma_f32_32x32x16_bf16(*(const LAS bf16x8*)(sb + koff + st * 4096 + (((2 * ds + hi) << 4) ^ fx)), qf[ds], S, 0, 0, 0);
            if (local) {
#pragma unroll
                for (int r = 0; r < 16; ++r) { const int dk = kb + crow(r, hi) - tq; if (dk > 128 || dk < -128) S[r] = -1e30f; }
            }
            bf16x8 pa0, pa1;
            softmax_step<2>(S, m, l, O, pa0, pa1);
#pragma unroll
            for (int d = 0; d < 2; ++d) {
                const bf16x8 v0 = *(const LAS bf16x8*)(sb + voff + d * 4096 + (((4 * st + hi) << 4) ^ fx)), v1 = *(const LAS bf16x8*)(sb + voff + d * 4096 + (((4 * st + 2 + hi) << 4) ^ fx));
                O[d] = __builtin_amdgcn_mfma_f32_32x32x16_bf16(v0, pa0, O[d], 0, 0, 0);
                O[d] = __builtin_amdgcn_mfma_f32_32x32x16_bf16(v1, pa1, O[d], 0, 0, 0);
            }
        }
#if ATT_SERIAL
        ATT_WAIT_BAR();
        if (i + 1 < NT) WIN_STAGE(i + 1, (i + 1) & 1);
#endif
    }
#undef WIN_STAGE
#undef WIN_KEY0
    l += __shfl_xor(l, 32);
    const float il = 1.0f / l;
    bf16_t* orow = CAT + (size_t)(b * SEQ + q0 + r32) * DM + 512 + hq * 64 + 4 * hi;
#pragma unroll
    for (int d = 0; d < 2; ++d)
#pragma unroll
        for (int g = 0; g < 4; ++g) {
            u32x2 w; w.x = cvt_pk_bf16(O[d][4 * g] * il, O[d][4 * g + 1] * il); w.y = cvt_pk_bf16(O[d][4 * g + 2] * il, O[d][4 * g + 3] * il);
            *(u32x2*)(orow + d * 32 + 8 * g) = w;
        }
    ATT_WAIT_BAR();
}

__device__ __forceinline__ void transpose64(const float* W, int ldw, int k0, int csrc, bf16_t* WT, int drow, LAS float* scr, int lane) {
#pragma unroll 4
    for (int i = 0; i < 16; ++i) {
        const int kk = (lane >> 4) + 4 * i;
        const f32x4 v = *(const f32x4*)(W + (size_t)(k0 + kk) * ldw + csrc + 4 * (lane & 15));
        LAS float* s = scr + kk * 65 + 4 * (lane & 15);
        s[0] = v[0]; s[1] = v[1]; s[2] = v[2]; s[3] = v[3];
    }
    LDS_WAIT(); asm volatile("" ::: "memory");
    const int c = lane & 7;
#pragma unroll
    for (int j = 0; j < 8; ++j) {
        const int n = (lane >> 3) + 8 * j; const LAS float* s = scr + (8 * c) * 65 + n;
        u32x4 o; o.x = pk2(s[0 * 65], s[1 * 65]); o.y = pk2(s[2 * 65], s[3 * 65]); o.z = pk2(s[4 * 65], s[5 * 65]); o.w = pk2(s[6 * 65], s[7 * 65]);
        *(u32x4*)(WT + (size_t)(drow + n) * 1024 + k0 + 8 * c) = o;
    }
    LDS_WAIT(); asm volatile("" ::: "memory");
}
__device__ __forceinline__ int wqk_srccol(int r) {
    if (r >= 1664) return -1;
    const int p = r & 63, d = (p >> 1) + 32 * (p & 1);
    return (r >> 6) * 64 + d + (r >= 1536 ? 512 : 0);
}
__device__ __forceinline__ void transpose64_wqk(const float* W, int k0, bf16_t* WT, int drow, LAS float* scr, int lane) {
    const int sc = wqk_srccol(drow + lane);
#pragma unroll 8
    for (int i = 0; i < 64; ++i) scr[i * 65 + lane] = (sc >= 0) ? W[(size_t)(k0 + i) * 2304 + sc] : 0.f;
    LDS_WAIT(); asm volatile("" ::: "memory");
    const int c = lane & 7;
#pragma unroll
    for (int j = 0; j < 8; ++j) {
        const int n = (lane >> 3) + 8 * j; const LAS float* s = scr + (8 * c) * 65 + n;
        u32x4 o; o.x = pk2(s[0 * 65], s[1 * 65]); o.y = pk2(s[2 * 65], s[3 * 65]); o.z = pk2(s[4 * 65], s[5 * 65]); o.w = pk2(s[6 * 65], s[7 * 65]);
        *(u32x4*)(WT + (size_t)(drow + n) * 1024 + k0 + 8 * c) = o;
    }
    LDS_WAIT(); asm volatile("" ::: "memory");
}

struct In {
    const float *x, *c, *ctx, *c_ctx, *mod_w, *mod_b, *ln_g, *ln_b, *attn_w_in, *attn_lambda, *attn_subln_g, *attn_sink, *attn_w_out,
        *hy_w_in, *hy_conv_w, *hy_conv_b, *hy_ffn_w_in, *hy_ffn_w_hid, *hy_ffn_b, *hy_sin_freq, *hy_ffn_w_out, *hy_skip, *hy_w_out,
        *router_w, *router_bias, *exp_w_gate, *exp_w_up, *exp_w_down;
};

struct TrItem { const float* src; bf16_t* dst; };
__device__ __forceinline__ TrItem expert_item(const In& I, unsigned char* ws, int it) {
    const int l = it / (16 * 768), item = it % (16 * 768);
    const int e = item / 768, r = item % 768, which = r >> 8, q = r & 255, kt = q >> 4, ci = q & 15;
    const size_t eoff = ((size_t)l * NEXP + e) * 1024 * 1024;
    TrItem t;
    if (which == 2) { t.src = I.exp_w_down + eoff + (size_t)(kt * 64) * 1024 + ci * 64; t.dst = (bf16_t*)(ws + WS_WD) + eoff + (size_t)(ci * 64) * 1024 + kt * 64; }
    else { t.src = (which == 0 ? I.exp_w_gate : I.exp_w_up) + eoff + (size_t)(kt * 64) * 1024 + ci * 64;
           t.dst = (bf16_t*)(ws + WS_WGU) + eoff * 2 + (size_t)((ci >> 1) * 256 + which * 128 + (ci & 1) * 64) * 1024 + kt * 64; }
    return t;
}
__device__ __forceinline__ void tr_load(const TrItem& t, f32x4 (&v)[16], int lane) {
#pragma unroll
    for (int i = 0; i < 16; ++i) v[i] = __builtin_nontemporal_load((const f32x4*)(t.src + (size_t)((lane >> 4) + 4 * i) * 1024 + 4 * (lane & 15)));
}
__device__ __forceinline__ void tr_store(const TrItem& t, const f32x4 (&v)[16], LAS float* scr, int lane) {
#pragma unroll
    for (int i = 0; i < 16; ++i) { LAS float* s = scr + ((lane >> 4) + 4 * i) * 65 + 4 * (lane & 15); s[0] = v[i][0]; s[1] = v[i][1]; s[2] = v[i][2]; s[3] = v[i][3]; }
    LDS_WAIT(); asm volatile("" ::: "memory");
    const int c = lane & 7;
#pragma unroll
    for (int j = 0; j < 8; ++j) {
        const int n = (lane >> 3) + 8 * j; const LAS float* s = scr + (8 * c) * 65 + n;
        u32x4 o; o.x = pk2(s[0 * 65], s[1 * 65]); o.y = pk2(s[2 * 65], s[3 * 65]); o.z = pk2(s[4 * 65], s[5 * 65]); o.w = pk2(s[6 * 65], s[7 * 65]);
        __builtin_nontemporal_store(o, (u32x4*)(t.dst + (size_t)n * 1024 + 8 * c));
    }
    LDS_WAIT(); asm volatile("" ::: "memory");
}

__device__ __forceinline__ void drain_convert_queue(const In& I, unsigned char* ws, LAS unsigned char* lds, int wave, int lane, int quota) {
    unsigned* head = (unsigned*)(ws + WS_CTL) + CW_Q1;
    LAS float* scr = (LAS float*)(lds + wave * 16640);
    for (int n = 0; n < quota; ++n) {
        unsigned it = 0u;
        if (lane == 0) it = atomicAdd(head, 1u);
        it = (unsigned)__builtin_amdgcn_readfirstlane((int)it);
        if (it >= 16u * 768u) break;
        const TrItem t = expert_item(I, ws, 16 * 768 + (int)it);
        f32x4 v[16];
        tr_load(t, v, lane); tr_store(t, v, scr, lane);
    }
}
__device__ __forceinline__ int idle_quota(int U, int bid, int G, int per_round) {
    const int maxu = (U + G - 1) / G, mine = (bid < U) ? (U - bid + G - 1) / G : 0;
    return (maxu - mine) * per_round;
}

__device__ __forceinline__ void phase_prep(const In& I, unsigned char* ws, LAS unsigned char* lds, int tid, int lane, int wave, int bid, int G) {
    if (bid < 96) {
        LAS float* sl = (LAS float*)lds;
        LAS float* part = (LAS float*)(lds + 36864);
        for (int i = tid; i < 9 * 1024; i += 512) { const float v = (i < 8192) ? I.c[i] : I.c_ctx[i - 8192]; sl[i] = v / (1.0f + expf(-v)); }
        __syncthreads();
        const int l = bid / 48, cgp = bid % 48, cgi = tid & 31, ks = tid >> 5, col = cgp * 128 + 4 * cgi;
        f32x4 acc[9];
#pragma unroll
        for (int r = 0; r < 9; ++r) acc[r] = (f32x4){0.f, 0.f, 0.f, 0.f};
#pragma unroll 2
        for (int kk = 0; kk < 64; ++kk) {
            const int k = ks * 64 + kk;
            const f32x4 w = *(const f32x4*)(I.mod_w + ((size_t)l * 1024 + k) * 6144 + col);
#pragma unroll
            for (int r = 0; r < 9; ++r) acc[r] += w * sl[r * 1024 + k];
        }
#pragma unroll
        for (int r = 0; r < 9; ++r) { LAS float* p = part + (ks * 9 + r) * 128 + 4 * cgi; p[0] = acc[r][0]; p[1] = acc[r][1]; p[2] = acc[r][2]; p[3] = acc[r][3]; }
        __syncthreads();
        float* MOD = (float*)(ws + WS_MOD);
        for (int idx = tid; idx < 9 * 128; idx += 512) {
            const int r = idx >> 7, cc = idx & 127; float s = I.mod_b[l * 6144 + cgp * 128 + cc];
#pragma unroll
            for (int k2 = 0; k2 < 16; ++k2) s += part[(k2 * 9 + r) * 128 + cc];
            MOD[(size_t)(l * 9 + r) * 6144 + cgp * 128 + cc] = s;
        }
        __syncthreads();
    }
    for (int item = bid; item < 256; item += G) {
        LAS float* z = (LAS float*)lds;
        LAS float* h1 = z + 8 * 33;
        LAS float* h2 = h1 + 512;
        LAS float* h3 = h2 + 512;
        const int pos0 = item * 8;
        if (tid < 8 * 33) {
            const int p = tid / 33, f = tid % 33, pos = pos0 + p;
            const float tt = (float)pos / 2047.0f, w = 6.283185307179586f * (float)pos / 2048.0f;
            float v;
            if (f == 0) v = tt;
            else { const int bi = (f - 1) & 15; const float fr = 1e-4f + (float)bi * ((15.0f - 1e-4f) / 15.0f); v = (f <= 16) ? cosf(fr * w) : -sinf(fr * w); }
            z[p * 33 + f] = v;
        }
        __syncthreads();
        const int p = tid >> 6, j = tid & 63;
        { float a = I.hy_ffn_b[j];
_Pragma("unroll 4")
          for (int f = 0; f < 33; ++f) a += z[p * 33 + f] * I.hy_ffn_w_in[f * 64 + j];
          h1[p * 64 + j] = sinf(I.hy_sin_freq[j] * a); }
        __syncthreads();
        { float a = I.hy_ffn_b[64 + j];
_Pragma("unroll 4")
          for (int f = 0; f < 64; ++f) a += h1[p * 64 + f] * I.hy_ffn_w_hid[f * 64 + j];
          h2[p * 64 + j] = sinf(I.hy_sin_freq[64 + j] * a); }
        __syncthreads();
        { float a = I.hy_ffn_b[128 + j];
_Pragma("unroll 4")
          for (int f = 0; f < 64; ++f) a += h2[p * 64 + f] * I.hy_ffn_w_hid[4096 + f * 64 + j];
          h3[p * 64 + j] = sinf(I.hy_sin_freq[128 + j] * a); }
        __syncthreads();
        const int col = tid * 8;
        f32x4 a0[8], a1[8];
#pragma unroll
        for (int q = 0; q < 8; ++q) { a0[q] = (f32x4){0.f, 0.f, 0.f, 0.f}; a1[q] = (f32x4){0.f, 0.f, 0.f, 0.f}; }
#pragma unroll 2
        for (int k = 0; k < 64; ++k) {
            const f32x4 w0 = *(const f32x4*)(I.hy_ffn_w_out + (size_t)k * 4096 + col), w1 = *(const f32x4*)(I.hy_ffn_w_out + (size_t)k * 4096 + col + 4);
#pragma unroll
            for (int q = 0; q < 8; ++q) { const float hv = h3[q * 64 + k]; a0[q] += w0 * hv; a1[q] += w1 * hv; }
        }
        bf16_t* KREV = (bf16_t*)(ws + WS_KFB);
#pragma unroll
        for (int cc = 0; cc < 8; ++cc) {
            const int colq = col + cc, dir = colq >> 11, o = (colq >> 10) & 1, ch = colq & 1023;
            const float delta = fabsf(-3.0701134573253944f + (float)ch * ((-15.350567286626972f + 3.0701134573253944f) / 1023.0f));
            float v[8];
#pragma unroll
            for (int q = 0; q < 8; ++q) { const float tt = (float)(pos0 + q) / 2047.0f; const float a = (cc < 4) ? a0[q][cc & 3] : a1[q][cc & 3]; v[q] = a * expf(-tt * delta); }
            bf16_t* row = KREV + ((size_t)(o * 1024 + ch)) * 4096;
            if (dir == 0) {
                u32x4 wv; wv.x = pk2(v[7], v[6]); wv.y = pk2(v[5], v[4]); wv.z = pk2(v[3], v[2]); wv.w = pk2(v[1], v[0]);
                *(u32x4*)(row + 2040 - pos0) = wv;
            } else {
#pragma unroll
                for (int q = 0; q < 8; ++q) if (pos0 + q >= 1) row[2047 + pos0 + q] = (bf16_t)f2bf(v[q]);
                if (pos0 == 0) row[4095] = 0;
            }
        }
        __syncthreads();
    }
    {
        const int gt = bid * 512 + tid, NT = G * 512;
        float* rope = (float*)(ws + WS_ROPE);
        for (int i = gt; i < 2048 * 32; i += NT) {
            const int t = i >> 5, dd = i & 31; const int pidx = (dd < 16) ? (t >> 6) : (t & 63); const int fi = dd & 15;
            const float inv = powf(10000.0f, -(float)(2 * fi) / 32.0f); const float ang = (float)pidx * inv;
            rope[2 * i] = cosf(ang); rope[2 * i + 1] = sinf(ang);
        }
        unsigned* wvpad = (unsigned*)((bf16_t*)(ws + WS_WV) + 640 * 1024);
        for (int i = gt; i < 128 * 1024 / 2; i += NT) wvpad[i] = 0u;
    }
    {
        LAS float* scr = (LAS float*)(lds + wave * 16640);
        const int gw = bid * 8 + wave, NGW = G * 8;
        constexpr int I_QK = 16 * 28, I_V = 16 * 10, I_O = 256, I_HI = 16 * 48, I_HO = 256, I_SMALL = I_QK + I_V + I_O + I_HI + I_HO;
        for (int it = gw; it < I_SMALL; it += NGW) {
            int r = it;
            if (r < I_QK) { transpose64_wqk(I.attn_w_in, (r / 28) * 64, (bf16_t*)(ws + WS_WQK), (r % 28) * 64, scr, lane); continue; } r -= I_QK;
            if (r < I_V) { const int ct = r % 10, kt = r / 10; transpose64(I.attn_w_in, 2304, kt * 64, (ct < 8) ? 1536 + ct * 64 : 2176 + (ct - 8) * 64, (bf16_t*)(ws + WS_WV), ct * 64, scr, lane); continue; } r -= I_V;
            if (r < I_O) { transpose64(I.attn_w_out, 1024, (r >> 4) * 64, (r & 15) * 64, (bf16_t*)(ws + WS_WO), (r & 15) * 64, scr, lane); continue; } r -= I_O;
            if (r < I_HI) { transpose64(I.hy_w_in, 3072, (r / 48) * 64, (r % 48) * 64, (bf16_t*)(ws + WS_HIN), (r % 48) * 64, scr, lane); continue; } r -= I_HI;
            transpose64(I.hy_w_out, 1024, (r >> 4) * 64, (r & 15) * 64, (bf16_t*)(ws + WS_HOUT), (r & 15) * 64, scr, lane);
        }
        {
            constexpr int NIT = 2 * 16 * 768;
            f32x4 va[16], vb[16];
            int it = gw;
            TrItem ta = expert_item(I, ws, it), tb = ta;
            tr_load(ta, va, lane);
            while (it < NIT) {
                const int itn = it + NGW;
                if (itn < NIT) { tb = expert_item(I, ws, itn); tr_load(tb, vb, lane); }
                tr_store(ta, va, scr, lane);
                it = itn; if (it >= NIT) break;
                const int itn2 = it + NGW;
                if (itn2 < NIT) { ta = expert_item(I, ws, itn2); tr_load(ta, va, lane); }
                tr_store(tb, vb, scr, lane);
                it = itn2;
            }
        }
    }
}

__device__ __forceinline__ void phase_modulate0(const In& I, unsigned char* ws, int lane, int gw, int NGW) {
    const float* MOD = (const float*)(ws + WS_MOD);
    bf16_t* HA = (bf16_t*)(ws + WS_HA); bf16_t* HC = (bf16_t*)(ws + WS_Y);
    for (int row = gw; row < TOK + CTOK; row += NGW) {
        const float* src; const float* mv; bf16_t* dst;
        if (row < TOK) { src = I.x + (size_t)row * DM; mv = MOD + (size_t)(row >> 11) * 6144; dst = HA + (size_t)row * DM; }
        else { const int r2 = row - TOK; src = I.ctx + (size_t)r2 * DM; mv = MOD + (size_t)8 * 6144; dst = HC + (size_t)r2 * DM; }
#pragma unroll
        for (int j = 0; j < 4; ++j) {
            const int d = 4 * (lane + 64 * j);
            const f32x4 v = *(const f32x4*)(src + d), sh = *(const f32x4*)(mv + d), sc = *(const f32x4*)(mv + 1024 + d);
            const f32x4 h = v * (sc + 1.0f) + sh;
            u32x2 w; w.x = pk2(h[0], h[1]); w.y = pk2(h[2], h[3]);
            *(u32x2*)(dst + d) = w;
        }
    }
}

__device__ __forceinline__ void phase_ln1_router(const In& I, unsigned char* ws, LAS unsigned char* lds, int l, int tid, int lane, int wave, int gw, int NGW) {
    LAS float* wT = (LAS float*)lds;
    for (int i = tid; i < 16384; i += 512) { const int d = i >> 4, e = i & 15; wT[e * 1024 + d] = I.router_w[i]; }
    const float* MOD = (const float*)(ws + WS_MOD) + (size_t)l * 9 * 6144;
    const bf16_t* Y = (const bf16_t*)(ws + WS_Y);
    float* XR = (float*)(ws + WS_XR); bf16_t* HA = (bf16_t*)(ws + WS_HA);
    int* slot_tok = (int*)(ws + WS_SLOT); float* slot_w = (float*)(ws + WS_SLOT + MiB);
    int* cnt = (int*)(ws + WS_CTL) + CW_CNT + l * 16 * 64;
    LAS int* lcnt = (LAS int*)(lds + 65536);
    if (tid < 32) lcnt[tid] = 0;
    __syncthreads();
    const float* lg = I.ln_g + (size_t)(l * 2) * DM; const float* lb = I.ln_b + (size_t)(l * 2) * DM;
    float rbias[16];
#pragma unroll
    for (int e = 0; e < 16; ++e) rbias[e] = I.router_bias[e];
    for (int r0 = gw * 8; r0 < TOK; r0 += NGW * 8) {
        const float* mv = MOD + (size_t)(r0 >> 11) * 6144;
        f32x4 g1v[4], lgv[4], lbv[4], scv[4], shv[4];
#pragma unroll
        for (int j = 0; j < 4; ++j) { const int d = 4 * (lane + 64 * j); g1v[j] = *(const f32x4*)(mv + 2048 + d); lgv[j] = *(const f32x4*)(lg + d); lbv[j] = *(const f32x4*)(lb + d); scv[j] = *(const f32x4*)(mv + 4096 + d) + 1.0f; shv[j] = *(const f32x4*)(mv + 3072 + d); }
#pragma unroll 2
        for (int ri = 0; ri < 8; ++ri) {
            const int row = r0 + ri;
            f32x4 v[4]; float s = 0.f;
#pragma unroll
            for (int j = 0; j < 4; ++j) {
                const int d = 4 * (lane + 64 * j);
                const f32x4 xv = *(const f32x4*)(((l == 0) ? I.x : (const float*)XR) + (size_t)row * DM + d);
                const u32x2 yw = *(const u32x2*)(Y + (size_t)row * DM + d);
                const f32x4 yv = (f32x4){bflo(yw.x), bfhi(yw.x), bflo(yw.y), bfhi(yw.y)};
                v[j] = xv * DN_ALPHA + g1v[j] * yv; s += (v[j][0] + v[j][1]) + (v[j][2] + v[j][3]);
            }
            const float mean = wave_sum(s) * (1.0f / DM); float s2 = 0.f;
#pragma unroll
            for (int j = 0; j < 4; ++j) { v[j] = v[j] - mean; s2 += (v[j][0] * v[j][0] + v[j][1] * v[j][1]) + (v[j][2] * v[j][2] + v[j][3] * v[j][3]); }
            const float rstd = 1.0f / sqrtf(wave_sum(s2) * (1.0f / DM) + LN_EPS);
            float lgt[16];
#pragma unroll
            for (int e = 0; e < 16; ++e) lgt[e] = 0.f;
#pragma unroll
            for (int j = 0; j < 4; ++j) {
                const int d = 4 * (lane + 64 * j);
                const f32x4 x1 = v[j] * rstd * lgv[j] + lbv[j];
                *(f32x4*)(XR + (size_t)row * DM + d) = x1;
                const f32x4 h2 = x1 * scv[j] + shv[j];
                u32x2 w; w.x = pk2(h2[0], h2[1]); w.y = pk2(h2[2], h2[3]);
                *(u32x2*)(HA + (size_t)row * DM + d) = w;
#pragma unroll
                for (int e = 0; e < 16; ++e) { const f32x4 wv = *(const LAS f32x4*)(wT + e * 1024 + d); lgt[e] += (h2[0] * wv[0] + h2[1] * wv[1]) + (h2[2] * wv[2] + h2[3] * wv[3]); }
                asm volatile("" ::: "memory");
            }
            float r8[8], r4[4], r2[2], r1;
#pragma unroll
            for (int k = 0; k < 8; ++k) { const bool up = (lane & 32) != 0; const float keep = up ? lgt[k + 8] : lgt[k], send = up ? lgt[k] : lgt[k + 8]; r8[k] = keep + __shfl_xor(send, 32); }
#pragma unroll
            for (int k = 0; k < 4; ++k) { const bool up = (lane & 16) != 0; const float keep = up ? r8[k + 4] : r8[k], send = up ? r8[k] : r8[k + 4]; r4[k] = keep + __shfl_xor(send, 16); }
#pragma unroll
            for (int k = 0; k < 2; ++k) { const bool up = (lane & 8) != 0; const float keep = up ? r4[k + 2] : r4[k], send = up ? r4[k] : r4[k + 2]; r2[k] = keep + __shfl_xor(send, 8); }
            { const bool up = (lane & 4) != 0; const float keep = up ? r2[1] : r2[0], send = up ? r2[0] : r2[1]; r1 = keep + __shfl_xor(send, 4); }
            r1 += __shfl_xor(r1, 2); r1 += __shfl_xor(r1, 1);
#pragma unroll
            for (int e = 0; e < 16; ++e) lgt[e] = __shfl(r1, ((e >> 3) & 1) * 32 + ((e >> 2) & 1) * 16 + ((e >> 1) & 1) * 8 + (e & 1) * 4);
            float mx = lgt[0];
#pragma unroll
            for (int e = 1; e < 16; ++e) mx = fmaxf(mx, lgt[e]);
            float sc[16], den = 0.f;
#pragma unroll
            for (int e = 0; e < 16; ++e) { sc[e] = expf(lgt[e] - mx); den += sc[e]; }
            const float iden = 1.0f / den;
            float sel[16];
#pragma unroll
            for (int e = 0; e < 16; ++e) { sc[e] *= iden; sel[e] = sc[e] + rbias[e]; }
            float bgs = -1e30f; int e0 = 0, e1 = 0; float w0 = 0.f, w1 = 0.f;
#pragma unroll
            for (int g = 0; g < 4; ++g) {
                int i0 = 0; float v0 = sel[4 * g];
#pragma unroll
                for (int k = 1; k < 4; ++k) if (sel[4 * g + k] > v0) { v0 = sel[4 * g + k]; i0 = k; }
                int i1 = -1; float v1 = -1e30f;
#pragma unroll
                for (int k = 0; k < 4; ++k) if (k != i0 && sel[4 * g + k] > v1) { v1 = sel[4 * g + k]; i1 = k; }
                const float gs = v0 + v1;
                if (gs > bgs) {
                    bgs = gs; e0 = 4 * g + i0; e1 = 4 * g + i1;
                    float sa = 0.f, sb = 0.f;
#pragma unroll
                    for (int k = 0; k < 4; ++k) { sa = (k == i0) ? sc[4 * g + k] : sa; sb = (k == i1) ? sc[4 * g + k] : sb; }
                    w0 = sa; w1 = sb;
                }
            }
            const float wn = 1.0f / (w0 + w1);
            if (lane == 0) {
                const int p0 = __hip_atomic_fetch_add(lcnt + e0, 1, __ATOMIC_RELAXED, __HIP_MEMORY_SCOPE_WORKGROUP), p1 = __hip_atomic_fetch_add(lcnt + e1, 1, __ATOMIC_RELAXED, __HIP_MEMORY_SCOPE_WORKGROUP);
                const int li = wave * 8 + ri;
                lcnt[32 + 2 * li] = p0; lcnt[33 + 2 * li] = p1; lcnt[160 + 2 * li] = e0; lcnt[161 + 2 * li] = e1;
                ((LAS float*)lcnt)[288 + 2 * li] = w0 * wn; ((LAS float*)lcnt)[289 + 2 * li] = w1 * wn;
            }
        }
    }
    __syncthreads();
    if (tid < 16) lcnt[16 + tid] = atomicAdd(cnt + 64 * tid, lcnt[tid]);
    __syncthreads();
    for (int r0 = gw * 8; r0 < TOK; r0 += NGW * 8) {
        if (lane < 16) { const int ri = lane >> 1, k = lane & 1, li = wave * 8 + ri, e = lcnt[160 + 2 * li + k], pos = lcnt[16 + e] + lcnt[32 + 2 * li + k];
            slot_tok[e * SLOT_CAP + pos] = (r0 + ri) * 2 + k; slot_w[e * SLOT_CAP + pos] = ((LAS float*)lcnt)[288 + 2 * li + k]; }
    }
}

__device__ __forceinline__ void build_moe_tabs(unsigned char* ws, LAS unsigned char* lds, int l, int tid, int bid, int G, bool gather) {
    const int* cnt = (const int*)(ws + WS_CTL) + CW_CNT + l * 16 * 64;
    LAS int* rbtab = (LAS int*)(lds + RBTAB_OFF); LAS int* rbloc = rbtab + 160; LAS int* ecnt = rbtab + 320;
    if (tid < 160) {
        int e = -1, acc = 0, loc = 0;
        for (int i = 0; i < 16; ++i) { const int c = __hip_atomic_load(cnt + 64 * i, __ATOMIC_RELAXED, __HIP_MEMORY_SCOPE_AGENT); const int nb = (c + 255) >> 8; if (e < 0 && tid < acc + nb) { e = i; loc = tid - acc; } acc += nb; }
        rbtab[tid] = e; rbloc[tid] = loc;
    }
    if (tid < 16) ecnt[tid] = __hip_atomic_load(cnt + 64 * tid, __ATOMIC_RELAXED, __HIP_MEMORY_SCOPE_AGENT);
    if (tid == 16) { int acc = 0; for (int i = 0; i < 16; ++i) { const int c = __hip_atomic_load(cnt + 64 * i, __ATOMIC_RELAXED, __HIP_MEMORY_SCOPE_AGENT); acc += (c + 255) >> 8; } rbtab[336] = acc; }
    __syncthreads();
    if (gather) {
        const int* slot_tok = (const int*)(ws + WS_SLOT);
        LAS unsigned* gtab = (LAS unsigned*)(lds + GTAB_OFF);
        for (int idx = tid; idx < 5 * 256; idx += 512) {
            const int i = idx >> 8, r = idx & 255, rb = (i * G + bid) >> 3;
            unsigned off = 0u;
            if (rb < MAXBLK) { const int e = rbtab[rb]; if (e >= 0) { const int slot = rbloc[rb] * 256 + r; if (slot < ecnt[e]) off = (unsigned)(slot_tok[e * SLOT_CAP + slot] >> 1) * 2048u; } }
            gtab[idx] = off;
        }
        __syncthreads();
    }
}

__device__ __forceinline__ void phase_ln2(const In& I, unsigned char* ws, int l, float* out, int lane, int gw, int NGW) {
    const float* MOD = (const float*)(ws + WS_MOD);
    float* XR = (float*)(ws + WS_XR); bf16_t* HA = (bf16_t*)(ws + WS_HA); const bf16_t* F2 = (const bf16_t*)(ws + WS_R2);
    const float* lg = I.ln_g + (size_t)(l * 2 + 1) * DM; const float* lb = I.ln_b + (size_t)(l * 2 + 1) * DM;
    for (int r0 = gw * 8; r0 < TOK; r0 += NGW * 8) {
        const float* mv = MOD + (size_t)(l * 9 + (r0 >> 11)) * 6144; const float* mv1 = MOD + (size_t)(9 + (r0 >> 11)) * 6144;
        f32x4 g2v[4], lgv[4], lbv[4], scv[4], shv[4];
#pragma unroll
        for (int j = 0; j < 4; ++j) { const int d = 4 * (lane + 64 * j); g2v[j] = *(const f32x4*)(mv + 5120 + d); lgv[j] = *(const f32x4*)(lg + d); lbv[j] = *(const f32x4*)(lb + d);
            scv[j] = *(const f32x4*)(mv1 + 1024 + d) + 1.0f; shv[j] = *(const f32x4*)(mv1 + d); }
#pragma unroll 2
        for (int ri = 0; ri < 8; ++ri) {
            const int row = r0 + ri;
            f32x4 v[4]; float s = 0.f;
#pragma unroll
            for (int j = 0; j < 4; ++j) {
                const int d = 4 * (lane + 64 * j);
                const f32x4 xv = *(const f32x4*)(XR + (size_t)row * DM + d);
                const u32x2 fa = *(const u32x2*)(F2 + (size_t)(row * 2) * DM + d), fb = *(const u32x2*)(F2 + (size_t)(row * 2 + 1) * DM + d);
                const f32x4 fv = (f32x4){bflo(fa.x) + bflo(fb.x), bfhi(fa.x) + bfhi(fb.x), bflo(fa.y) + bflo(fb.y), bfhi(fa.y) + bfhi(fb.y)};
                v[j] = xv * DN_ALPHA + g2v[j] * fv; s += (v[j][0] + v[j][1]) + (v[j][2] + v[j][3]);
            }
            const float mean = wave_sum(s) * (1.0f / DM); float s2 = 0.f;
#pragma unroll
            for (int j = 0; j < 4; ++j) { v[j] = v[j] - mean; s2 += (v[j][0] * v[j][0] + v[j][1] * v[j][1]) + (v[j][2] * v[j][2] + v[j][3] * v[j][3]); }
            const float rstd = 1.0f / sqrtf(wave_sum(s2) * (1.0f / DM) + LN_EPS);
#pragma unroll
            for (int j = 0; j < 4; ++j) {
                const int d = 4 * (lane + 64 * j);
                const f32x4 x2 = v[j] * rstd * lgv[j] + lbv[j];
                if (l == 0) {
                    *(f32x4*)(XR + (size_t)row * DM + d) = x2;
                    const f32x4 h = x2 * scv[j] + shv[j];
                    u32x2 w; w.x = pk2(h[0], h[1]); w.y = pk2(h[2], h[3]);
                    *(u32x2*)(HA + (size_t)row * DM + d) = w;
                } else *(f32x4*)(out + (size_t)row * DM + d) = x2;
            }
        }
    }
}

constexpr int HY_YOFF = 2176;
constexpr int HY_ZP = 0;
constexpr int HY_RAW = 36864;
constexpr int HY_TC = 45056;
constexpr int HY_TCP = 8976;
constexpr int HY_GATE = HY_TC + 8 * HY_TCP;
static_assert(HY_GATE + 32768 <= MISC_OFF, "hyena LDS");
__device__ __forceinline__ int hy_zrow(int bb) { return HY_ZP + bb * 4624 - (bb >> 2) * 64; }
__device__ __forceinline__ int hy_tcbase(int m) { const int off = (0x035089ACu >> (4 * m)) & 15; return HY_TC + m * HY_TCP + (((off - m) & 15) << 4); }

__device__ __forceinline__ u32x4 hy_conv8(const bf16_t* urow, int t0, float w0, float w1, float w2, float bias) {
    const u32x4 v = *(const u32x4*)(urow + t0);
    float u[10];
    u[0] = (t0 > 0) ? bf2f(urow[t0 - 1]) : 0.f; u[9] = (t0 + 8 < SEQ) ? bf2f(urow[t0 + 8]) : 0.f;
    u[1] = bflo(v.x); u[2] = bfhi(v.x); u[3] = bflo(v.y); u[4] = bfhi(v.y); u[5] = bflo(v.z); u[6] = bfhi(v.z); u[7] = bflo(v.w); u[8] = bfhi(v.w);
    float o[8];
#pragma unroll
    for (int j = 0; j < 8; ++j) o[j] = u[j] * w0 + u[j + 1] * w1 + u[j + 2] * w2 + bias;
    u32x4 r; r.x = pk2(o[0], o[1]); r.y = pk2(o[2], o[3]); r.z = pk2(o[4], o[5]); r.w = pk2(o[6], o[7]);
    return r;
}
__device__ __forceinline__ void hy_build_tc(LAS unsigned char* lds, int tid) {
    const LAS unsigned* raw = (const LAS unsigned*)(lds + HY_RAW);
    for (int i = tid; i < 8 * 2180; i += 512) {
        const int m = i / 2180, w = i - m * 2180, q = 2 * w + m - 129;
        unsigned val;
        if (q & 1) {
            const int wa = (q - 1) >> 1;
            const unsigned a = (wa >= 0 && wa < 2048) ? raw[wa] : 0u, b = (wa + 1 >= 0 && wa + 1 < 2048) ? raw[wa + 1] : 0u;
            val = (a >> 16) | (b << 16);
        } else { const int wa = q >> 1; val = (wa >= 0 && wa < 2048) ? raw[wa] : 0u; }
        *(LAS unsigned*)(lds + hy_tcbase(m) + 4 * w) = val;
    }
}
__device__ __forceinline__ void hy_conv(LAS unsigned char* lds, int wave, int lane, f32x16& acc0, f32x16& acc1) {
    asm volatile("" : "+v"(lane));
    const int r32 = lane & 31, hi = lane >> 5, m = (8 - (r32 & 7)) & 7, il = r32 >> 3, bb = r32 & 7;
    const LAS unsigned char* abase = lds + hy_tcbase(m) + ((HY_YOFF - r32 - m) >> 3) * 16 + hi * 16;
    const LAS unsigned char* zbase = lds + hy_zrow(bb) + (32 * (il + 3) + 8 * hi) * 2;
#pragma unroll
    for (int r = 0; r < 16; ++r) { acc0[r] = 0.f; acc1[r] = 0.f; }
    const int G0 = 2 * wave, G1 = 2 * wave + 1;
    for (int D = 8 * wave - 63; D < 8 * wave - 59; ++D) {
        const bf16x8 a0 = *(const LAS bf16x8*)(abase + (-4 * D) * 16), a1 = *(const LAS bf16x8*)(abase + (-4 * D + 2) * 16);
        const int j0 = 4 * G0 - D;
        const bf16x8 b0 = *(const LAS bf16x8*)(zbase + (32 * j0) * 2), b1 = *(const LAS bf16x8*)(zbase + (32 * j0 + 16) * 2);
        acc0 = __builtin_amdgcn_mfma_f32_32x32x16_bf16(a0, b0, acc0, 0, 0, 0);
        acc0 = __builtin_amdgcn_mfma_f32_32x32x16_bf16(a1, b1, acc0, 0, 0, 0);
    }
    {
#define HY_LOAD(D_, a0, a1, b0, b1, c0, c1) do { const int d_ = (D_); a0 = *(const LAS bf16x8*)(abase + (-4 * d_) * 16); a1 = *(const LAS bf16x8*)(abase + (-4 * d_ + 2) * 16); \
        const int j0_ = 4 * G0 - d_; b0 = *(const LAS bf16x8*)(zbase + (32 * j0_) * 2); b1 = *(const LAS bf16x8*)(zbase + (32 * j0_ + 16) * 2); \
        c0 = *(const LAS bf16x8*)(zbase + (32 * j0_ + 128) * 2); c1 = *(const LAS bf16x8*)(zbase + (32 * j0_ + 144) * 2); } while (0)
#define HY_MMA(a0, a1, b0, b1, c0, c1) do { acc0 = __builtin_amdgcn_mfma_f32_32x32x16_bf16(a0, b0, acc0, 0, 0, 0); acc1 = __builtin_amdgcn_mfma_f32_32x32x16_bf16(a0, c0, acc1, 0, 0, 0); \
        acc0 = __builtin_amdgcn_mfma_f32_32x32x16_bf16(a1, b1, acc0, 0, 0, 0); acc1 = __builtin_amdgcn_mfma_f32_32x32x16_bf16(a1, c1, acc1, 0, 0, 0); } while (0)
        bf16x8 pa0, pa1, pb0, pb1, pc0, pc1, qa0, qa1, qb0, qb1, qc0, qc1;
        const int Ds = 8 * wave - 59;
        HY_LOAD(Ds, pa0, pa1, pb0, pb1, pc0, pc1);
        for (int D = Ds; D < Ds + 62; D += 2) {
            HY_LOAD(D + 1, qa0, qa1, qb0, qb1, qc0, qc1);
            HY_MMA(pa0, pa1, pb0, pb1, pc0, pc1);
            HY_LOAD(D + 2, pa0, pa1, pb0, pb1, pc0, pc1);
            HY_MMA(qa0, qa1, qb0, qb1, qc0, qc1);
        }
        HY_MMA(pa0, pa1, pb0, pb1, pc0, pc1);
#undef HY_LOAD
#undef HY_MMA
    }
    for (int D = 8 * wave + 4; D <= 8 * wave + 7; ++D) {
        const bf16x8 a0 = *(const LAS bf16x8*)(abase + (-4 * D) * 16), a1 = *(const LAS bf16x8*)(abase + (-4 * D + 2) * 16);
        const int j1 = 4 * G1 - D;
        const bf16x8 c0 = *(const LAS bf16x8*)(zbase + (32 * j1) * 2), c1 = *(const LAS bf16x8*)(zbase + (32 * j1 + 16) * 2);
        acc1 = __builtin_amdgcn_mfma_f32_32x32x16_bf16(a0, c0, acc1, 0, 0, 0);
        acc1 = __builtin_amdgcn_mfma_f32_32x32x16_bf16(a1, c1, acc1, 0, 0, 0);
    }
}
__device__ __forceinline__ void phase_hyena(const In& I, unsigned char* ws, LAS unsigned char* lds, int tid, int lane, int wave, int bid, int G) {
    const bf16_t* UT = (const bf16_t*)(ws + WS_BIG); const bf16_t* KREV = (const bf16_t*)(ws + WS_KFB); bf16_t* Z2T = (bf16_t*)(ws + WS_R2);
    const int r32 = lane & 31, hi = lane >> 5, il = r32 >> 3, bb = r32 & 7;
    for (int i = tid; i < 8 * 6 * 32; i += 512) { const int b = i / 192, q = i % 192, blk = q >> 5, e = q & 31; const int pos = (blk < 3 ? blk : 64 + blk) * 32 + e; *(LAS bf16_t*)(lds + hy_zrow(b) + pos * 2) = 0; }
    for (int c = bid; c < DM; c += G) {
        __syncthreads();
        {
            const float w0 = I.hy_conv_w[c], w1 = I.hy_conv_w[3072 + c], w2 = I.hy_conv_w[6144 + c], bs = I.hy_conv_b[c];
            const float x0 = I.hy_conv_w[1024 + c], x1 = I.hy_conv_w[3072 + 1024 + c], x2 = I.hy_conv_w[6144 + 1024 + c], xb = I.hy_conv_b[1024 + c];
            const bf16_t* vrow = UT + (size_t)c * TOK; const bf16_t* xrow = UT + (size_t)(1024 + c) * TOK;
#pragma unroll
            for (int k = 0; k < 4; ++k) {
                const int i = tid + 512 * k, b = i >> 8, t0 = (i & 255) * 8;
                *(LAS u32x4*)(lds + hy_zrow(b) + (96 + t0) * 2) = hy_conv8(vrow + (size_t)b * SEQ, t0, w0, w1, w2, bs);
                *(LAS u32x4*)(lds + HY_GATE + (b * SEQ + t0) * 2) = hy_conv8(xrow + (size_t)b * SEQ, t0, x0, x1, x2, xb);
            }
            *(LAS u32x4*)(lds + HY_RAW + tid * 16) = *(const u32x4*)(KREV + (size_t)c * 4096 + tid * 8);
        }
        __syncthreads();
        hy_build_tc(lds, tid);
        __syncthreads();
        f32x16 acc0, acc1;
        hy_conv(lds, wave, lane, acc0, acc1);
        __syncthreads();
        const u32x4 rawn = *(const u32x4*)(KREV + (size_t)(1024 + c) * 4096 + tid * 8);
        {
            const float sk = I.hy_skip[c];
#pragma unroll
            for (int g = 0; g < 2; ++g)
#pragma unroll
                for (int q = 0; q < 4; ++q) {
                    const int t0 = 32 * (4 * (2 * wave + g) + il) + 8 * q + 4 * hi;
                    LAS u32x2* zp = (LAS u32x2*)(lds + hy_zrow(bb) + (96 + t0) * 2);
                    const u32x2 vz = *zp, gx = *(const LAS u32x2*)(lds + HY_GATE + (bb * SEQ + t0) * 2);
                    float a[4];
#pragma unroll
                    for (int j = 0; j < 4; ++j) a[j] = (g == 0) ? acc0[4 * q + j] : acc1[4 * q + j];
                    u32x2 o; o.x = pk2(bflo(gx.x) * (a[0] + bflo(vz.x) * sk), bfhi(gx.x) * (a[1] + bfhi(vz.x) * sk)); o.y = pk2(bflo(gx.y) * (a[2] + bflo(vz.y) * sk), bfhi(gx.y) * (a[3] + bfhi(vz.y) * sk));
                    *zp = o;
                }
        }
        *(LAS u32x4*)(lds + HY_RAW + tid * 16) = rawn;
        __syncthreads();
        {
            const float x0 = I.hy_conv_w[2048 + c], x1 = I.hy_conv_w[3072 + 2048 + c], x2 = I.hy_conv_w[6144 + 2048 + c], xb = I.hy_conv_b[2048 + c];
            const bf16_t* xrow = UT + (size_t)(2048 + c) * TOK;
#pragma unroll
            for (int k = 0; k < 4; ++k) { const int i = tid + 512 * k, b = i >> 8, t0 = (i & 255) * 8; *(LAS u32x4*)(lds + HY_GATE + (b * SEQ + t0) * 2) = hy_conv8(xrow + (size_t)b * SEQ, t0, x0, x1, x2, xb); }
        }
        hy_build_tc(lds, tid);
        __syncthreads();
        hy_conv(lds, wave, lane, acc0, acc1);
        {
            const float sk = I.hy_skip[1024 + c];
            bf16_t* orow = Z2T + (size_t)c * TOK + (size_t)bb * SEQ;
#pragma unroll
            for (int g = 0; g < 2; ++g)
#pragma unroll
                for (int q = 0; q < 4; ++q) {
                    const int t0 = 32 * (4 * (2 * wave + g) + il) + 8 * q + 4 * hi;
                    const u32x2 vz = *(const LAS u32x2*)(lds + hy_zrow(bb) + (96 + t0) * 2), gx = *(const LAS u32x2*)(lds + HY_GATE + (bb * SEQ + t0) * 2);
                    float a[4];
#pragma unroll
                    for (int j = 0; j < 4; ++j) a[j] = (g == 0) ? acc0[4 * q + j] : acc1[4 * q + j];
                    u32x2 o; o.x = pk2(bflo(gx.x) * (a[0] + bflo(vz.x) * sk), bfhi(gx.x) * (a[1] + bfhi(vz.x) * sk)); o.y = pk2(bflo(gx.y) * (a[2] + bflo(vz.y) * sk), bfhi(gx.y) * (a[3] + bfhi(vz.y) * sk));
                    *(u32x2*)(orow + t0) = o;
                }
        }
    }
}
__device__ __forceinline__ void phase_transpose_z2(unsigned char* ws, LAS unsigned char* lds, int lane, int wave, int gw, int NGW) {
    const bf16_t* Z2T = (const bf16_t*)(ws + WS_R2); bf16_t* Z2 = (bf16_t*)(ws + WS_R2 + 32 * MiB);
    LAS bf16_t* scr = (LAS bf16_t*)(lds + wave * 8704);
    for (int it = gw; it < 16 * 256; it += NGW) {
        const int c0 = (it & 15) * 64, t0 = (it >> 4) * 64;
#pragma unroll
        for (int i = 0; i < 8; ++i) {
            const int cc = (lane >> 3) + 8 * i; const u32x4 v = *(const u32x4*)(Z2T + (size_t)(c0 + cc) * TOK + t0 + 8 * (lane & 7));
            LAS unsigned* d = (LAS unsigned*)(scr + cc * 68 + 8 * (lane & 7)); d[0] = v.x; d[1] = v.y; d[2] = v.z; d[3] = v.w;
        }
        LDS_WAIT(); asm volatile("" ::: "memory");
#pragma unroll
        for (int i = 0; i < 8; ++i) {
            const int tt = (lane >> 3) + 8 * i, cb = 8 * (lane & 7);
            unsigned short e[8];
#pragma unroll
            for (int q = 0; q < 8; ++q) e[q] = scr[(cb + q) * 68 + tt];
            u32x4 w; w.x = e[0] | ((unsigned)e[1] << 16); w.y = e[2] | ((unsigned)e[3] << 16); w.z = e[4] | ((unsigned)e[5] << 16); w.w = e[6] | ((unsigned)e[7] << 16);
            *(u32x4*)(Z2 + (size_t)(t0 + tt) * DM + c0 + cb) = w;
        }
        LDS_WAIT(); asm volatile("" ::: "memory");
    }
}

#ifndef DIAG
#define DIAG 0
#endif
#if DIAG
constexpr int CW_CK = 3200;
__device__ __forceinline__ void diag_cksum(unsigned char* ws, int slot, const void* p, size_t bytes, int gw, int NGW, int lane) {
    const u32x4* q = (const u32x4*)p; const size_t n = bytes / 16; unsigned x = 0u;
    for (size_t i = (size_t)gw * 64 + lane; i < n; i += (size_t)NGW * 64) { const u32x4 v = q[i]; x ^= v.x ^ (v.y * 3u) ^ (v.z * 5u) ^ (v.w * 7u) ^ (unsigned)i * 2654435761u * (v.x + v.w); }
#pragma unroll
    for (int o = 1; o < 64; o <<= 1) x ^= (unsigned)__shfl_xor((int)x, o);
    if (lane == 0) atomicXor((unsigned*)(ws + WS_CTL) + CW_CK + slot, x);
}
#define DIAG_CK(slot, ptr, bytes) diag_cksum(ws, slot, ptr, bytes, gw, NGW, lane)
#else
#define DIAG_CK(slot, ptr, bytes) do { } while (0)
#endif
struct Args { const float* in[28]; float* out; unsigned char* ws; int ph_lo, ph_hi; };
static_assert(sizeof(Args) == 28 * 8 + 8 + 8 + 8, "Args has no padding");

__global__ void __launch_bounds__(512, 2) mega_fwd(Args args) {
    extern __shared__ __attribute__((aligned(16))) unsigned char lds_raw[];
    LAS unsigned char* lds = (LAS unsigned char*)lds_raw;
    typedef const __attribute__((address_space(4))) Args* KArgP;
    KArgP kap0 = (KArgP)__builtin_amdgcn_kernarg_segment_ptr();
    volatile LAS unsigned* MISC = (volatile LAS unsigned*)(lds + MISC_OFF);
    const int wave0 = __builtin_amdgcn_readfirstlane((int)threadIdx.x >> 6);
    if (wave0 == 0 && lane_id() < 32) MISC[lane_id()] = 0u;
    __syncthreads();
    const int lo = args.ph_lo, hi = args.ph_hi;
    XcdBarrier bar; bar.bar = (unsigned*)(args.ws + WS_CTL) + CW_BAR; bar.x = 0; bar.st = nullptr;
    if (hi - lo > 1) bar = xcd_barrier_post((unsigned*)(args.ws + WS_CTL) + CW_BAR, MISC + 8, wave0);
#define PHASE_BEGIN() KArgP kap = kap0; asm volatile("" : "+s"(kap)); int lane = lane_id(); asm volatile("" : "+v"(lane)); \
    const int wave = wave0, tid = wave * 64 + lane, bid = blockIdx.x, G = gridDim.x, gw = bid * 8 + wave, NGW = G * 8; \
    unsigned char* ws = kap->ws; const char* wsc = (const char*)ws; In I; \
    I.x = kap->in[0]; I.c = kap->in[1]; I.ctx = kap->in[2]; I.c_ctx = kap->in[3]; I.mod_w = kap->in[4]; I.mod_b = kap->in[5]; I.ln_g = kap->in[6]; I.ln_b = kap->in[7]; \
    I.attn_w_in = kap->in[8]; I.attn_lambda = kap->in[9]; I.attn_subln_g = kap->in[10]; I.attn_sink = kap->in[11]; I.attn_w_out = kap->in[12]; \
    I.hy_w_in = kap->in[13]; I.hy_conv_w = kap->in[14]; I.hy_conv_b = kap->in[15]; I.hy_ffn_w_in = kap->in[16]; I.hy_ffn_w_hid = kap->in[17]; I.hy_ffn_b = kap->in[18]; \
    I.hy_sin_freq = kap->in[19]; I.hy_ffn_w_out = kap->in[20]; I.hy_skip = kap->in[21]; I.hy_w_out = kap->in[22]; I.router_w = kap->in[23]; I.router_bias = kap->in[24]; \
    I.exp_w_gate = kap->in[25]; I.exp_w_up = kap->in[26]; I.exp_w_down = kap->in[27]; (void)wsc; (void)I; (void)lane; (void)wave; (void)gw; (void)NGW
#ifndef DUP_MASK
#define DUP_MASK 0
#endif
#define REP(k) for (int rep_ = 0; rep_ < 1 + (((DUP_MASK) >> (k)) & 1); ++rep_)
#define IN_PH(k) ((((PHASE_MASK) >> (k)) & 1) && lo <= (k) && (k) < hi)
#define SEAM(k) do { if (IN_PH(k) && IN_PH((k) + 1)) xcd_barrier(bar, wave0); else __syncthreads(); } while (0)
#define ONE_SEG(S, a, b, na, nb, fa) pg8::SegSched S; S.nseg = 1; S.G = G; S.c = bid; S.s[0] = pg8::Seg{a, b, na, nb, fa, 0}; S.s[1] = S.s[0]; S.s[2] = S.s[0]; S.s[3] = S.s[0]

    if (IN_PH(0)) { REP(0) { PHASE_BEGIN(); phase_prep(I, ws, lds, tid, lane, wave, bid, G); __syncthreads(); } SEAM(0); }
    if (IN_PH(1)) { REP(1) { PHASE_BEGIN(); DIAG_CK(0, ws + WS_MOD, 442368); phase_modulate0(I, ws, lane, gw, NGW); } SEAM(1); }
    if (IN_PH(2)) { REP(2) {
        PHASE_BEGIN();
        pg8::SegSched S; S.nseg = 4; S.G = G; S.c = bid;
        S.s[0] = pg8::Seg{wsc + WS_HA, wsc + WS_WQK, 64, 7, 1, 0};
        S.s[1] = pg8::Seg{wsc + WS_WV, wsc + WS_HA, 3, 64, 0, 2};
        S.s[2] = pg8::Seg{wsc + WS_Y, wsc + WS_WQK + 4 * pg8::TSTEP, 8, 3, 1, 1};
        S.s[3] = pg8::Seg{wsc + WS_WV, wsc + WS_Y, 3, 8, 0, 3};
        EpiProj E; E.P.QA = (bf16_t*)(ws + WS_R2 + R2_QA); E.P.QW = (bf16_t*)(ws + WS_R2 + R2_QW); E.P.KA = (bf16_t*)(ws + WS_R2 + R2_KA); E.P.VAT = (bf16_t*)(ws + WS_R2 + R2_VAT);
        E.P.KW = (bf16_t*)(ws + WS_R2 + R2_KW); E.P.VWT = (bf16_t*)(ws + WS_R2 + R2_VWT); E.P.rope = (const float*)(ws + WS_ROPE);
        pg8::gemm_phase(lds, S, E, tid); } SEAM(2);
    }
    if (IN_PH(3)) { REP(3) {
        PHASE_BEGIN(); DIAG_CK(1, ws + WS_R2, 77 * MiB);
        const bf16_t* QA = (const bf16_t*)(ws + WS_R2 + R2_QA); const bf16_t* QW = (const bf16_t*)(ws + WS_R2 + R2_QW); const bf16_t* KA = (const bf16_t*)(ws + WS_R2 + R2_KA);
        const bf16_t* VAT = (const bf16_t*)(ws + WS_R2 + R2_VAT); const bf16_t* KW = (const bf16_t*)(ws + WS_R2 + R2_KW); const bf16_t* VWT = (const bf16_t*)(ws + WS_R2 + R2_VWT);
        bf16_t* CAT = (bf16_t*)(ws + WS_BIG);
        float sa = 0.f, sb = 0.f;
        { const float a = I.attn_lambda[lane] * I.attn_lambda[64 + lane], b2 = I.attn_lambda[128 + lane] * I.attn_lambda[192 + lane]; sa = wave_sum(a); sb = wave_sum(b2); }
        const float lam = expf(sa) - expf(sb) + 0.2f;
        for (int u = bid; u < 256; u += G) { const int b = u >> 5, h = (u >> 3) & 3, qb = u & 7; diff_attn_block(lds, QA, KA, VAT, CAT, I.attn_subln_g, lam, b, h, qb, wave, lane); }
        for (int u = bid; u < 512; u += G) { const int b = u >> 6, hkv = (u >> 5) & 1, qblk = u & 31; win_attn_block(lds, QW, KW, VWT, CAT, I.attn_sink, b, hkv, qblk, wave, lane); }
        } SEAM(3);
    }
    if (IN_PH(4)) { REP(4) {
        PHASE_BEGIN(); DIAG_CK(2, ws + WS_BIG, 32 * MiB);
        ONE_SEG(S, wsc + WS_BIG, wsc + WS_WO, 64, 4, 1);
        EpiRowBf16 E{(bf16_t*)(ws + WS_Y), DM};
        pg8::gemm_phase(lds, S, E, tid); } SEAM(4);
    }
#define MOE_LAYER(l, pb) \
    if (IN_PH(pb)) { PHASE_BEGIN(); if (l == 0) DIAG_CK(3, ws + WS_Y, 32 * MiB); phase_ln1_router(I, ws, lds, l, tid, lane, wave, gw, NGW); SEAM(pb); } \
    if (IN_PH(pb + 2)) { REP(pb + 2) { PHASE_BEGIN(); if (l == 0) DIAG_CK(4, ws + WS_XR, 64 * MiB); build_moe_tabs(ws, lds, l, tid, bid, G, true); \
        pg8::MoeSched S{wsc + WS_HA, wsc + WS_WGU + (size_t)l * 64 * MiB, (const LAS int*)(lds + RBTAB_OFF), 8, G, bid, true}; \
        EpiGateUp E{(bf16_t*)(ws + WS_BIG)}; \
        pg8::gemm_phase<EpiGateUp, pg8::MoeSched, true>(lds, S, E, tid, (const LAS unsigned*)(lds + GTAB_OFF)); } SEAM(pb + 2); } \
    if (IN_PH(pb + 3)) { REP(pb + 3) { PHASE_BEGIN(); build_moe_tabs(ws, lds, l, tid, bid, G, false); \
        pg8::MoeSched S{wsc + WS_BIG, wsc + WS_WD + (size_t)l * 32 * MiB, (const LAS int*)(lds + RBTAB_OFF), 4, G, bid, false}; \
        EpiDown E{(bf16_t*)(ws + WS_R2), (const int*)(ws + WS_SLOT), (const float*)(ws + WS_SLOT + MiB), (const LAS int*)(lds + RBTAB_OFF) + 160, (const LAS int*)(lds + RBTAB_OFF) + 320}; \
        pg8::gemm_phase(lds, S, E, tid); } SEAM(pb + 3); } \
    if (IN_PH(pb + 4)) { PHASE_BEGIN(); if (l == 0) DIAG_CK(5, ws + WS_R2, 64 * MiB); phase_ln2(I, ws, l, kap->out, lane, gw, NGW); SEAM(pb + 4); }

    MOE_LAYER(0, 5)
    if (IN_PH(10)) { REP(10) {
        PHASE_BEGIN(); DIAG_CK(6, ws + WS_XR, 64 * MiB);
        ONE_SEG(S, wsc + WS_HIN, wsc + WS_HA, 12, 64, 0);
        EpiRowBf16 E{(bf16_t*)(ws + WS_BIG), TOK};
        pg8::gemm_phase(lds, S, E, tid); } SEAM(10);
    }
    if (IN_PH(11)) { REP(11) { PHASE_BEGIN(); phase_hyena(I, ws, lds, tid, lane, wave, bid, G); __syncthreads(); } SEAM(11); }
    if (IN_PH(12)) { REP(12) { PHASE_BEGIN(); phase_transpose_z2(ws, lds, lane, wave, gw, NGW); } SEAM(12); }
    if (IN_PH(13)) { REP(13) {
        PHASE_BEGIN();
        ONE_SEG(S, wsc + WS_R2 + 32 * MiB, wsc + WS_HOUT, 64, 4, 1);
        EpiRowBf16 E{(bf16_t*)(ws + WS_Y), DM};
        pg8::gemm_phase(lds, S, E, tid); } SEAM(13);
    }
    MOE_LAYER(1, 14)
#if DIAG
    if (hi - lo > 1) {
        xcd_barrier(bar, wave0);
        { PHASE_BEGIN(); DIAG_CK(7, kap->out, (size_t)TOK * DM * 4); }
        xcd_barrier(bar, wave0);
        { PHASE_BEGIN(); (void)tid;
          unsigned* ck = (unsigned*)(ws + WS_CTL) + CW_CK; unsigned* st = (unsigned*)(ws + WS_ROUTE);
          unsigned code = __hip_atomic_load(st + 8, __ATOMIC_RELAXED, __HIP_MEMORY_SCOPE_AGENT);
          if (code == 0xAAAAAAAAu) code = 0u;
          if (code == 0u) { for (int k = 7; k >= 0; --k) { const unsigned pv = __hip_atomic_load(st + k, __ATOMIC_RELAXED, __HIP_MEMORY_SCOPE_AGENT), cv = __hip_atomic_load(ck + k, __ATOMIC_RELAXED, __HIP_MEMORY_SCOPE_AGENT); if (pv != 0xAAAAAAAAu && pv != cv) code = (unsigned)k + 1u; } }
          xcd_barrier(bar, wave0);
          if (bid == 0 && wave == 0 && lane == 0) { for (int k = 0; k < 8; ++k) st[k] = __hip_atomic_load(ck + k, __ATOMIC_RELAXED, __HIP_MEMORY_SCOPE_AGENT); st[8] = code; }
          if (code) { const int nrows = 1024 * (int)code; for (int row = gw; row < nrows; row += NGW) for (int j = lane; j < DM; j += 64) kap->out[(size_t)row * DM + j] = 0.f; }
        }
    }
#endif
#undef IN_PH
#undef SEAM
}

extern "C" void kernel_launch(void* const* d_in, const int* in_sizes, int n_in, void* d_out, int out_size, void* d_ws, size_t ws_size, hipStream_t stream) {
    static int grid = 0;
    if (grid == 0) {
        if (n_in != 28 || in_sizes[0] != TOK * DM || out_size != TOK * DM || ws_size < WS_END) {
            fprintf(stderr, "kernel_launch: unexpected problem (n_in %d, in0 %d, out %d, ws %zu < %zu); nothing launched\n", n_in, n_in > 0 ? in_sizes[0] : -1, out_size, ws_size, (size_t)WS_END); grid = -1; return; }
        int dev = 0, cus = 0, per_cu = 0;
        if (hipGetDevice(&dev) != hipSuccess || hipDeviceGetAttribute(&cus, hipDeviceAttributeMultiprocessorCount, dev) != hipSuccess) { fprintf(stderr, "kernel_launch: device query failed\n"); grid = -1; return; }
        if (hipFuncSetAttribute((const void*)mega_fwd, hipFuncAttributeMaxDynamicSharedMemorySize, LDS_BYTES) != hipSuccess) { fprintf(stderr, "kernel_launch: hipFuncSetAttribute failed\n"); grid = -1; return; }
        if (hipOccupancyMaxActiveBlocksPerMultiprocessor(&per_cu, (const void*)mega_fwd, 512, LDS_BYTES) != hipSuccess || per_cu < 1)
            fprintf(stderr, "kernel_launch: note: occupancy query reports %d workgroups per CU\n", per_cu);
        (void)hipGetLastError();
        grid = cus;
    }
    if (grid < 0) return;
    if (hipMemsetAsync((char*)d_ws + WS_CTL, 0, CTL_ZERO_BYTES, stream) != hipSuccess) { fprintf(stderr, "kernel_launch: memset failed\n"); return; }
    Args a{};
    for (int i = 0; i < 28; ++i) a.in[i] = (const float*)d_in[i];
    a.out = (float*)d_out; a.ws = (unsigned char*)d_ws;
    if (MK_N_LAUNCHES == 1) { a.ph_lo = 0; a.ph_hi = NPH; hipLaunchKernelGGL(mega_fwd, dim3(grid), dim3(512), LDS_BYTES, stream, a); }
    else for (int p = 0; p < NPH; ++p) { a.ph_lo = p; a.ph_hi = p + 1; hipLaunchKernelGGL(mega_fwd, dim3(grid), dim3(512), LDS_BYTES, stream, a); }
    const hipError_t le = hipPeekAtLastError();
    if (le != hipSuccess) fprintf(stderr, "kernel_launch: launch failed: %s\n", hipGetErrorName(le));
}
```

```cpp
#include <hip/hip_runtime.h>
#include <cstdio>
#include <cstdint>

#define LAS __attribute__((address_space(3)))
#define GAS __attribute__((address_space(1)))
typedef unsigned short bf16_t;
typedef short bf16x8 __attribute__((ext_vector_type(8)));
typedef short s16x4 __attribute__((ext_vector_type(4)));
typedef float f32x2 __attribute__((ext_vector_type(2)));
typedef float f32x4 __attribute__((ext_vector_type(4)));
typedef float f32x16 __attribute__((ext_vector_type(16)));
typedef unsigned u32x2 __attribute__((ext_vector_type(2)));
typedef unsigned u32x4 __attribute__((ext_vector_type(4)));

#ifndef PHASE_MASK
#define PHASE_MASK 0x7ffff
#endif
#ifndef MK_N_LAUNCHES
#define MK_N_LAUNCHES 1
#endif

constexpr int NB = 8, SEQ = 2048, DM = 1024, TOK = NB * SEQ, CTXL = 256, CTOK = NB * CTXL, KEYS = SEQ + CTXL;
constexpr int NEXP = 16, MAXBLK = 144, MAXROWS = MAXBLK * 256;
constexpr float LN_EPS = 1e-5f, DN_ALPHA = 1.41421356237309515f, LOG2E = 1.4426950408889634f;
constexpr float QSCALE = 0.125f * LOG2E;
constexpr int NPH = 19;

constexpr size_t MiB = 1u << 20;
constexpr size_t WS_CTL = 0, CTL_ZERO_BYTES = 64 * 1024;
constexpr size_t WS_MOD = 1 * MiB;
constexpr size_t WS_ROPE = WS_MOD + MiB / 2;
constexpr size_t WS_ROUTE = 2 * MiB;
constexpr size_t WS_WQK = 3 * MiB;
constexpr size_t WS_WV = WS_WQK + 3584 * 1024;
constexpr size_t WS_WO = 8 * MiB;
constexpr size_t WS_HIN = 10 * MiB;
constexpr size_t WS_HOUT = 16 * MiB;
constexpr size_t WS_KFB = 18 * MiB;
constexpr size_t WS_WGU = 34 * MiB;
constexpr size_t WS_WD = 162 * MiB;
constexpr size_t WS_HA = 226 * MiB;
constexpr size_t WS_XR = 258 * MiB;
constexpr size_t WS_Y = 322 * MiB;
constexpr size_t WS_R2 = 354 * MiB;
constexpr size_t WS_BIG = 432 * MiB;
constexpr size_t WS_SLOT = 528 * MiB;
constexpr size_t WS_END = 530 * MiB;
constexpr size_t R2_QA = 0, R2_QW = 16 * MiB, R2_KA = 32 * MiB, R2_VAT = 50 * MiB, R2_KW = 68 * MiB, R2_VWT = R2_KW + 4608 * 1024;
constexpr int SLOT_CAP = 16384;
constexpr int CW_CNT = 64;
constexpr int CW_Q1 = 3072;
constexpr int CW_BAR = 4096;

constexpr int RING_BYTES = 131072;
constexpr int MISC_OFF = 158720;
constexpr int GTAB_OFF = 131072;
constexpr int RBTAB_OFF = 137216;
constexpr int LDS_BYTES = 159744;

__device__ __forceinline__ unsigned f2bf(float f) { unsigned u = __builtin_bit_cast(unsigned, f); return (u + 0x7fffu + ((u >> 16) & 1u)) >> 16; }
__device__ __forceinline__ unsigned pk2(float lo, float hi) { return f2bf(lo) | (f2bf(hi) << 16); }
__device__ __forceinline__ float bf2f(unsigned b) { return __builtin_bit_cast(float, b << 16); }
__device__ __forceinline__ float bflo(unsigned w) { return __builtin_bit_cast(float, w << 16); }
__device__ __forceinline__ float bfhi(unsigned w) { return __builtin_bit_cast(float, w & 0xffff0000u); }
typedef __bf16 bf16x2_t __attribute__((ext_vector_type(2)));
__device__ __forceinline__ unsigned cvt_pk_bf16(float lo, float hi) { const f32x2 v = {lo, hi}; const bf16x2_t b = __builtin_convertvector(v, bf16x2_t); return __builtin_bit_cast(unsigned, b); }
#define LDS_WAIT() asm volatile("s_waitcnt lgkmcnt(0)" ::: "memory")
#define VM_WAIT() asm volatile("s_waitcnt vmcnt(0)" ::: "memory")
__device__ __forceinline__ float wave_sum(float v) {
#pragma unroll
    for (int o = 1; o < 64; o <<= 1) v += __shfl_xor(v, o);
    return v;
}
__device__ __forceinline__ int crow(int r, int hi) { return (r & 3) + 8 * (r >> 2) + 4 * hi; }

#define XB_TMO      128
#define XB_XCNT(j)  (256  + 64 * (j))
#define XB_XSUB(j)  (1280 + 64 * (j))
#define XB_XGEN(j)  (2304 + 64 * (j))
#define XB_TOP      3328
#define XB_TOPGEN   3392
#define XCD_BAR_WORDS 3456
#define XB_SPIN_CAP (1u << 18)
static_assert((CW_BAR + XCD_BAR_WORDS) * 4 <= (int)CTL_ZERO_BYTES, "barrier words inside the memset region");
__device__ __forceinline__ unsigned xb_ld(unsigned* p)              { return __hip_atomic_load(p, __ATOMIC_RELAXED, __HIP_MEMORY_SCOPE_AGENT); }
__device__ __forceinline__ unsigned xb_add(unsigned* p, unsigned v) { return __hip_atomic_fetch_add(p, v, __ATOMIC_RELAXED, __HIP_MEMORY_SCOPE_AGENT); }
__device__ __forceinline__ unsigned xb_xcc_id() { return (unsigned)__builtin_amdgcn_s_getreg((3 << 11) | 20) & 0xFu; }
#define XB_SPIN(cond, bar) do { unsigned _sp = 0; while (cond) { __builtin_amdgcn_s_sleep(1); \
    if ((++_sp & 255u) == 0u) { if (xb_ld(&(bar)[XB_TMO])) break; if (_sp > XB_SPIN_CAP) { atomicAdd(&(bar)[XB_TMO], 1u); break; } } } } while (0)
struct XcdBarrier { unsigned* bar; unsigned x; volatile LAS unsigned* st; };
__device__ __forceinline__ int lane_id() { return (int)__builtin_amdgcn_mbcnt_hi(~0u, __builtin_amdgcn_mbcnt_lo(~0u, 0u)); }
__device__ __forceinline__ XcdBarrier xcd_barrier_post(unsigned* bar, volatile LAS unsigned* st, int wave) {
    XcdBarrier b; b.bar = bar; b.x = xb_xcc_id(); b.st = st;
    if (wave == 0 && lane_id() == 0) (void)xb_add(&bar[XB_XCNT(b.x)], 1u);
    return b;
}
__device__ __forceinline__ void xcd_barrier_complete(unsigned* bar, unsigned x, unsigned& nloc, unsigned& nx) {
    const unsigned G = gridDim.x * gridDim.y * gridDim.z;
    unsigned sum, cnt, mine, sp = 0u;
    for (;;) {
        sum = 0u; cnt = 0u; mine = 0u;
#pragma unroll
        for (unsigned j = 0; j < 16; ++j) { const unsigned c = xb_ld(&bar[XB_XCNT(j)]); sum += c; cnt += (c > 0u) ? 1u : 0u; mine = (j == x) ? c : mine; }
        if (sum == G) break;
        __builtin_amdgcn_s_sleep(1);
        if ((++sp & 255u) == 0u) { if (xb_ld(&bar[XB_TMO])) break; if (sp > XB_SPIN_CAP) { atomicAdd(&bar[XB_TMO], 1u); break; } }
    }
    nloc = mine > 0u ? mine : 1u; nx = cnt > 0u ? cnt : 1u;
}
__device__ __forceinline__ void xcd_barrier(const XcdBarrier& b, int wave) {
    asm volatile("s_waitcnt vmcnt(0)" ::: "memory");
    __syncthreads();
    if (wave == 0 && lane_id() == 0) {
        unsigned* bar = b.bar;
        __builtin_amdgcn_s_waitcnt(0);
        unsigned nloc = b.st[0], nx = b.st[1];
        if (nloc == 0u) { xcd_barrier_complete(bar, b.x, nloc, nx); b.st[0] = nloc; b.st[1] = nx; }
        const unsigned old = xb_add(&bar[XB_XSUB(b.x)], 1u);
        const unsigned gen = old / nloc;
        if (old + 1u == (gen + 1u) * nloc) {
            __builtin_amdgcn_fence(__ATOMIC_RELEASE, "agent");
            asm volatile("s_waitcnt vmcnt(0)" ::: "memory");
            const unsigned og = xb_add(&bar[XB_TOP], 1u);
            const unsigned tg = og / nx;
            if (og + 1u == (tg + 1u) * nx) xb_add(&bar[XB_TOPGEN], 1u);
            else XB_SPIN(xb_ld(&bar[XB_TOPGEN]) == tg, bar);
            __builtin_amdgcn_fence(__ATOMIC_ACQUIRE, "agent");
            xb_add(&bar[XB_XGEN(b.x)], 1u);
            asm volatile("s_waitcnt vmcnt(0)" ::: "memory");
        } else {
            XB_SPIN(xb_ld(&bar[XB_XGEN(b.x)]) == gen, bar);
            __builtin_amdgcn_fence(__ATOMIC_ACQUIRE, "agent");
            asm volatile("s_waitcnt vmcnt(0)" ::: "memory");
        }
    }
    __syncthreads();
}

namespace pg8 {
constexpr int BM = 256, BK = 64, HALF = 128, HTB = HALF * BK * 2, STAGE_BYTES = 8 * HTB, KDIM = 1024;
constexpr size_t TSTEP = (size_t)BM * KDIM * 2;
__host__ __device__ __forceinline__ int lds_byte(int r, int c) { const int st = (r >> 4) * 2 + (c >> 5), rr = r & 15, cc = c & 31, ob = rr * 64 + cc * 2; return st * 1024 + (ob ^ (((ob >> 9) & 1) << 5)); }
__host__ __device__ __forceinline__ void stage_rc(int b, int& R, int& C) { const int st = b / 1024, sb = b % 1024, swz = sb ^ (((sb >> 9) & 1) << 5); R = (st >> 1) * 16 + swz / 64; C = (st & 1) * 32 + (swz % 64) / 2; }
__host__ __device__ __forceinline__ int perm32(int rho) { const int n = rho >> 4, i = rho & 15; return 8 * (i >> 2) + 4 * n + (i & 3); }
struct Unit { const char* A; const char* B; int r0, c0, kind, aux; };
template <class Epi, class Sched, bool GATHER = false>
__device__ __forceinline__ void gemm_phase(LAS unsigned char* lds, const Sched& S, const Epi& E, const int tid, const LAS unsigned* gtab = nullptr) {
    const int wid = __builtin_amdgcn_readfirstlane(tid >> 6), lane = tid & 63, wr = wid >> 2, wc = wid & 3, fr = lane & 15, fq = lane >> 4;
    constexpr int K = KDIM, nt = K / BK;
    unsigned voffA[2], voffB[2]; int gR[2]; unsigned gC[2];
    unsigned voA_hi[2], vnA_lo[2], vnA_hi[2];
#pragma unroll
    for (int i = 0; i < 2; ++i) { int R, C; stage_rc(tid * 16 + i * 8192, R, C); const int Rb = (R & ~31) + perm32(R & 31);
        voffA[i] = (unsigned)(R * K + C) * 2u; voffB[i] = (unsigned)(Rb * K + C) * 2u; gR[i] = R; gC[i] = (unsigned)C * 2u; voA_hi[i] = 0u; vnA_lo[i] = 0u; vnA_hi[i] = 0u; }
    const size_t kstep = (size_t)(BK * 2);
    const size_t hstep = (size_t)HALF * K * 2;
    const unsigned ldsw = (unsigned)wid * 1024u;
    const int aoff = lds_byte(wr * 64 + fr, fq * 8), boff = lds_byte(wc * 32 + fr, fq * 8);
#define PG8_SA(b, h) (((b) * 2 + (h)) * HTB)
#define PG8_SB(b, h) ((4 + (b) * 2 + (h)) * HTB)
#define PG8_STAGE(bufoff, gbase, voff) do { _Pragma("unroll") for (int _i = 0; _i < 2; ++_i) \
        __builtin_amdgcn_global_load_lds((const GAS unsigned*)((const char*)(gbase) + (voff)[_i]), (LAS unsigned*)(lds + (bufoff) + ldsw + _i * 8192), 16, 0, 0); } while (0)
#define PG8_LDA(dst, b, h) do { _Pragma("unroll") for (int m = 0; m < 4; ++m) _Pragma("unroll") for (int k = 0; k < 2; ++k) dst[m][k] = *(const LAS bf16x8*)(lds + PG8_SA(b, h) + aoff + m * 2048 + k * 1024); } while (0)
#define PG8_LDB(dst, b, h) do { _Pragma("unroll") for (int n = 0; n < 2; ++n) _Pragma("unroll") for (int k = 0; k < 2; ++k) dst[n][k] = *(const LAS bf16x8*)(lds + PG8_SB(b, h) + boff + n * 2048 + k * 1024); } while (0)
#define PG8_MMA(ai, bj, At, Bt) do { __builtin_amdgcn_s_setprio(1); _Pragma("unroll") for (int m = 0; m < 4; ++m) _Pragma("unroll") for (int n = 0; n < 2; ++n) _Pragma("unroll") for (int k = 0; k < 2; ++k) \
        acc[ai][bj][m][n] = __builtin_amdgcn_mfma_f32_16x16x32_bf16(Bt[n][k], At[m][k], acc[ai][bj][m][n], 0, 0, 0); __builtin_amdgcn_s_setprio(0); } while (0)
#define PG8_WAIT_V(n) asm volatile("s_waitcnt vmcnt(" #n ")" ::: "memory")
#define PG8_WAIT_L(n) asm volatile("s_waitcnt lgkmcnt(" #n ")" ::: "memory")
#define PG8_BAR __builtin_amdgcn_s_barrier()
#define PG8_SCHED __builtin_amdgcn_sched_barrier(0)
    Unit cur, nxt; int ui = 0;
    if (!S.next(0, cur)) return;
    f32x4 acc[2][2][4][2];
#pragma unroll
    for (int a = 0; a < 2; ++a)
#pragma unroll
        for (int b = 0; b < 2; ++b)
#pragma unroll
            for (int m = 0; m < 4; ++m)
#pragma unroll
                for (int n = 0; n < 2; ++n) acc[a][b][m][n] = (f32x4){0.f, 0.f, 0.f, 0.f};
    bf16x8 At[4][2], B0[2][2], B1[2][2];
    const char* cA = cur.A; const char* cB = cur.B;
    if constexpr (GATHER) {
#pragma unroll
        for (int i = 0; i < 2; ++i) { voffA[i] = gtab[gR[i]] + gC[i]; voA_hi[i] = gtab[128 + gR[i]] + gC[i]; }
    }
#define PG8_STAGE_HI(bufoff, gbase, cur_) do { if constexpr (GATHER) { unsigned vs_[2]; vs_[0] = (cur_) ? voA_hi[0] : vnA_hi[0]; vs_[1] = (cur_) ? voA_hi[1] : vnA_hi[1]; PG8_STAGE(bufoff, gbase, vs_); } else PG8_STAGE(bufoff, (gbase) + hstep, voffA); } while (0)
#define PG8_STAGE_LO(bufoff, gbase, cur_) do { if constexpr (GATHER) { unsigned vs_[2]; vs_[0] = (cur_) ? voffA[0] : vnA_lo[0]; vs_[1] = (cur_) ? voffA[1] : vnA_lo[1]; PG8_STAGE(bufoff, gbase, vs_); } else PG8_STAGE(bufoff, gbase, voffA); } while (0)
    PG8_STAGE(PG8_SB(0, 0), cB, voffB); PG8_STAGE(PG8_SB(0, 1), cB + hstep, voffB); PG8_STAGE(PG8_SA(0, 0), cA, voffA); PG8_STAGE_HI(PG8_SA(0, 1), cA, true);
    if (wr == 1) PG8_BAR;
    PG8_WAIT_V(2); PG8_BAR;
    PG8_STAGE(PG8_SB(1, 0), cB + kstep, voffB); PG8_STAGE(PG8_SA(1, 0), cA + kstep, voffA); PG8_STAGE(PG8_SB(1, 1), cB + hstep + kstep, voffB);
    PG8_WAIT_V(6); PG8_BAR;
    for (;;) {
        const bool has_next = S.next(ui + 1, nxt);
        const char* nA = has_next ? nxt.A : cA; const char* nB = has_next ? nxt.B : cB;
        if constexpr (GATHER) {
#pragma unroll
            for (int i = 0; i < 2; ++i) { vnA_lo[i] = has_next ? gtab[(ui + 1) * 256 + gR[i]] + gC[i] : voffA[i]; vnA_hi[i] = has_next ? gtab[(ui + 1) * 256 + 128 + gR[i]] + gC[i] : voA_hi[i]; }
        }
        for (int t = 0; t < nt; t += 2) {
            const bool last = (t == nt - 2);
            const char* a1 = cA + (size_t)(t + 1) * kstep;
            const char* a2 = last ? nA : cA + (size_t)(t + 2) * kstep; const char* b2 = last ? nB : cB + (size_t)(t + 2) * kstep;
            const char* a3 = a2 + kstep; const char* b3 = b2 + kstep;
            PG8_LDB(B0, 0, 0); PG8_LDB(B1, 0, 1); PG8_SCHED; PG8_LDA(At, 0, 0); PG8_STAGE_HI(PG8_SA(1, 1), a1, true);
            PG8_WAIT_V(8); PG8_WAIT_L(0); PG8_BAR; PG8_MMA(0, 0, At, B0); PG8_MMA(0, 1, At, B1); PG8_BAR; PG8_SCHED;
            PG8_LDA(At, 0, 1); PG8_STAGE(PG8_SB(0, 0), b2, voffB); PG8_STAGE(PG8_SB(0, 1), b2 + hstep, voffB); PG8_STAGE_LO(PG8_SA(0, 0), a2, !last);
            PG8_WAIT_V(8); PG8_WAIT_L(0); PG8_BAR; PG8_MMA(1, 0, At, B0); PG8_MMA(1, 1, At, B1); PG8_BAR; PG8_SCHED;
            PG8_LDB(B0, 1, 0); PG8_LDB(B1, 1, 1); PG8_SCHED; PG8_LDA(At, 1, 0); PG8_STAGE_HI(PG8_SA(0, 1), a2, !last);
            PG8_WAIT_V(8); PG8_WAIT_L(0); PG8_BAR; PG8_MMA(0, 0, At, B0); PG8_MMA(0, 1, At, B1); PG8_BAR; PG8_SCHED;
            PG8_LDA(At, 1, 1); PG8_STAGE(PG8_SB(1, 0), b3, voffB); PG8_STAGE(PG8_SB(1, 1), b3 + hstep, voffB); PG8_STAGE_LO(PG8_SA(1, 0), a3, !last);
            PG8_WAIT_V(8); PG8_WAIT_L(0); PG8_BAR; PG8_MMA(1, 0, At, B0); PG8_MMA(1, 1, At, B1); PG8_BAR; PG8_SCHED;
        }
        if (wr == 0) PG8_BAR;
        E(acc, cur, wr, wc, fr, fq);
        if (!has_next) break;
#pragma unroll
        for (int a = 0; a < 2; ++a)
#pragma unroll
            for (int b = 0; b < 2; ++b)
#pragma unroll
                for (int m = 0; m < 4; ++m)
#pragma unroll
                    for (int n = 0; n < 2; ++n) acc[a][b][m][n] = (f32x4){0.f, 0.f, 0.f, 0.f};
        cur = nxt; cA = nA; cB = nB; ++ui;
        if constexpr (GATHER) {
#pragma unroll
            for (int i = 0; i < 2; ++i) { voffA[i] = vnA_lo[i]; voA_hi[i] = vnA_hi[i]; }
        }
        if (wr == 1) PG8_BAR;
    }
    PG8_WAIT_V(0);
    PG8_BAR;
#undef PG8_SA
#undef PG8_SB
#undef PG8_STAGE
#undef PG8_STAGE_HI
#undef PG8_STAGE_LO
#undef PG8_LDA
#undef PG8_LDB
#undef PG8_MMA
#undef PG8_WAIT_V
#undef PG8_WAIT_L
#undef PG8_BAR
#undef PG8_SCHED
}

struct Seg { const char* A; const char* B; int nA, nB, fastA, kind; };
struct SegSched {
    Seg s[4]; int nseg, G, c;
    __device__ __forceinline__ bool next(int i, Unit& u) const {
        int L = i * G + c;
#pragma unroll
        for (int k = 0; k < 4; ++k) {
            if (k < nseg) {
                const int n = s[k].nA * s[k].nB;
                if (L < n) {
                    int ia, ib;
                    if (s[k].fastA) { ia = L % s[k].nA; ib = L / s[k].nA; } else { ib = L % s[k].nB; ia = L / s[k].nB; }
                    u.A = s[k].A + (size_t)ia * TSTEP; u.B = s[k].B + (size_t)ib * TSTEP; u.r0 = ia; u.c0 = ib; u.kind = s[k].kind; u.aux = 0; return true;
                }
                L -= n;
            }
        }
        return false;
    }
};
struct MoeSched {
    const char* A; const char* B; const LAS int* rbtab; int nct, G, c; bool gatherA;
    __device__ __forceinline__ bool next(int i, Unit& u) const {
        const int L = i * G + c; const int rb = L / nct, ct = L - rb * nct;
        if (rb >= MAXBLK) return false;
        const int e = rbtab[rb];
        if (e < 0) return false;
        u.A = gatherA ? A : A + (size_t)rb * TSTEP; u.B = B + (size_t)(e * nct + ct) * TSTEP; u.r0 = rb; u.c0 = e * nct + ct; u.kind = 0; u.aux = ct; return true;
    }
};
}

struct WsPtrs {
    bf16_t *QA, *QW, *KA, *VAT, *KW, *VWT;
    const float* rope;
};
struct EpiProj {
    WsPtrs P;
    __device__ __forceinline__ void operator()(const f32x4 (&acc)[2][2][4][2], const pg8::Unit& u, int wr, int wc, int fr, int fq) const {
        if (u.kind == 0 || u.kind == 1) {
#pragma unroll
            for (int bj = 0; bj < 2; ++bj) {
                const int gcol = (u.kind == 0 ? 0 : 1024) + u.c0 * 256 + bj * 128 + wc * 32 + fq * 8;
                if (gcol >= 1664) continue;
                const int p = gcol & 63;
#pragma unroll
                for (int ai = 0; ai < 2; ++ai)
#pragma unroll
                    for (int m = 0; m < 4; ++m) {
                        const int row = u.r0 * 256 + ai * 128 + wr * 64 + m * 16 + fr;
                        int b, t;
                        if (u.kind == 0) { b = row >> 11; t = row & 2047; } else { b = row >> 8; t = 2048 + (row & 255); }
                        f32x4 v0 = acc[ai][bj][m][0], v1 = acc[ai][bj][m][1];
                        if (u.kind == 0) {
                            const f32x4* rp = (const f32x4*)(P.rope + ((size_t)t * 32 + (p >> 1)) * 2);
                            const f32x4 c0 = rp[0], c1 = rp[1];
                            f32x4 o0, o1;
                            o0[0] = v0[0] * c0[0] - v0[1] * c0[1]; o0[1] = v0[1] * c0[0] + v0[0] * c0[1];
                            o0[2] = v0[2] * c0[2] - v0[3] * c0[3]; o0[3] = v0[3] * c0[2] + v0[2] * c0[3];
                            o1[0] = v1[0] * c1[0] - v1[1] * c1[1]; o1[1] = v1[1] * c1[0] + v1[0] * c1[1];
                            o1[2] = v1[2] * c1[2] - v1[3] * c1[3]; o1[3] = v1[3] * c1[2] + v1[2] * c1[3];
                            v0 = o0; v1 = o1;
                            if (gcol < 1024) { v0 = v0 * QSCALE; v1 = v1 * QSCALE; }
                        }
                        bf16_t* dst;
                        if (gcol < 512)       dst = P.QA + ((size_t)((b * 8 + (gcol >> 6)) * 2048 + t)) * 64 + p;
                        else if (gcol < 1024) dst = P.QW + ((size_t)((b * 8 + ((gcol - 512) >> 6)) * 2048 + t)) * 64 + p;
                        else if (gcol < 1536) dst = P.KA + ((size_t)((b * 8 + ((gcol - 1024) >> 6)) * KEYS + t)) * 64 + p;
                        else                  dst = P.KW + ((size_t)((b * 2 + ((gcol - 1536) >> 6)) * KEYS + t)) * 64 + p;
                        u32x4 w; w.x = cvt_pk_bf16(v0[0], v0[1]); w.y = cvt_pk_bf16(v0[2], v0[3]); w.z = cvt_pk_bf16(v1[0], v1[1]); w.w = cvt_pk_bf16(v1[2], v1[3]);
                        *(u32x4*)dst = w;
                    }
            }
        } else {
#pragma unroll
            for (int ai = 0; ai < 2; ++ai)
#pragma unroll
                for (int m = 0; m < 4; ++m) {
                    const int ch = u.r0 * 256 + ai * 128 + wr * 64 + m * 16 + fr;
                    if (ch >= 640) continue;
#pragma unroll
                    for (int bj = 0; bj < 2; ++bj) {
                        const int tk = u.c0 * 256 + bj * 128 + wc * 32 + fq * 8;
                        int b, t;
                        if (u.kind == 2) { b = tk >> 11; t = tk & 2047; } else { b = tk >> 8; t = 2048 + (tk & 255); }
                        bf16_t* dst;
                        if (ch < 512) dst = P.VAT + ((size_t)(b * 512 + ch)) * KEYS + (t & ~15);
                        else          dst = P.VWT + ((size_t)(b * 128 + (ch - 512))) * KEYS + (t & ~15);
                        const f32x4 v0 = acc[ai][bj][m][0], v1 = acc[ai][bj][m][1];
                        u32x2 wa, wb; wa.x = cvt_pk_bf16(v0[0], v0[1]); wa.y = cvt_pk_bf16(v0[2], v0[3]); wb.x = cvt_pk_bf16(v1[0], v1[1]); wb.y = cvt_pk_bf16(v1[2], v1[3]);
                        const int hi8 = (t >> 3) & 1;
                        *(u32x2*)(dst + 4 * hi8) = wa; *(u32x2*)(dst + 8 + 4 * hi8) = wb;
                    }
                }
        }
    }
};
struct EpiRowBf16 {
    bf16_t* O; int ld;
    __device__ __forceinline__ void operator()(const f32x4 (&acc)[2][2][4][2], const pg8::Unit& u, int wr, int wc, int fr, int fq) const {
#pragma unroll
        for (int ai = 0; ai < 2; ++ai)
#pragma unroll
            for (int m = 0; m < 4; ++m) {
                bf16_t* rowp = O + (size_t)(u.r0 * 256 + ai * 128 + wr * 64 + m * 16 + fr) * ld + u.c0 * 256 + wc * 32 + fq * 8;
#pragma unroll
                for (int bj = 0; bj < 2; ++bj) {
                    const f32x4 v0 = acc[ai][bj][m][0], v1 = acc[ai][bj][m][1];
                    u32x4 w; w.x = cvt_pk_bf16(v0[0], v0[1]); w.y = cvt_pk_bf16(v0[2], v0[3]); w.z = cvt_pk_bf16(v1[0], v1[1]); w.w = cvt_pk_bf16(v1[2], v1[3]);
                    *(u32x4*)(rowp + bj * 128) = w;
                }
            }
    }
};
struct EpiGateUp {
    bf16_t* ACT;
    __device__ __forceinline__ void operator()(const f32x4 (&acc)[2][2][4][2], const pg8::Unit& u, int wr, int wc, int fr, int fq) const {
#pragma unroll
        for (int ai = 0; ai < 2; ++ai)
#pragma unroll
            for (int m = 0; m < 4; ++m) {
                bf16_t* dst = ACT + (size_t)(u.r0 * 256 + ai * 128 + wr * 64 + m * 16 + fr) * 1024 + u.aux * 128 + wc * 32 + fq * 8;
                float o[8];
#pragma unroll
                for (int n = 0; n < 2; ++n)
#pragma unroll
                    for (int j = 0; j < 4; ++j) { const float g = acc[ai][0][m][n][j], up = acc[ai][1][m][n][j]; o[n * 4 + j] = g * __builtin_amdgcn_rcpf(1.0f + __expf(-g)) * up; }
                u32x4 w; w.x = cvt_pk_bf16(o[0], o[1]); w.y = cvt_pk_bf16(o[2], o[3]); w.z = cvt_pk_bf16(o[4], o[5]); w.w = cvt_pk_bf16(o[6], o[7]);
                *(u32x4*)dst = w;
            }
    }
};
struct EpiDown {
    bf16_t* F2; const int* slot_tok; const float* slot_w; const LAS int* rbloc; const LAS int* ecnt;
    __device__ __forceinline__ void operator()(const f32x4 (&acc)[2][2][4][2], const pg8::Unit& u, int wr, int wc, int fr, int fq) const {
        const int e = u.c0 >> 2, cnt = ecnt[e], sbase = rbloc[u.r0] * 256;
#pragma unroll
        for (int ai = 0; ai < 2; ++ai)
#pragma unroll
            for (int m = 0; m < 4; ++m) {
                const int slot = sbase + ai * 128 + wr * 64 + m * 16 + fr;
                if (slot >= cnt) continue;
                const int st = slot_tok[e * SLOT_CAP + slot]; const float wt = slot_w[e * SLOT_CAP + slot];
                bf16_t* rowp = F2 + (size_t)st * 1024 + u.aux * 256 + wc * 32 + fq * 8;
#pragma unroll
                for (int bj = 0; bj < 2; ++bj) {
                    const f32x4 v0 = acc[ai][bj][m][0] * wt, v1 = acc[ai][bj][m][1] * wt;
                    u32x4 w; w.x = cvt_pk_bf16(v0[0], v0[1]); w.y = cvt_pk_bf16(v0[2], v0[3]); w.z = cvt_pk_bf16(v1[0], v1[1]); w.w = cvt_pk_bf16(v1[2], v1[3]);
                    *(u32x4*)(rowp + bj * 128) = w;
                }
            }
    }
};

#ifndef ATT_SERIAL
#define ATT_SERIAL 0
#endif
#ifndef ATT_STAGGER
#define ATT_STAGGER 0
#endif
__device__ __forceinline__ float max3f(float a, float b, float c) { float r; asm("v_max3_f32 %0, %1, %2, %3" : "=v"(r) : "v"(a), "v"(b), "v"(c)); return r; }
template <int DVT>
__device__ __forceinline__ void softmax_step(f32x16& S, float& m, float& l, f32x16 (&O)[DVT], bf16x8& pb0, bf16x8& pb1) {
    asm volatile("s_nop 15\n\ts_nop 7" : "+v"(S));
    float ta = max3f(S[0], S[1], S[2]), tb = max3f(S[3], S[4], S[5]);
    ta = max3f(ta, S[6], S[7]); tb = max3f(tb, S[8], S[9]); ta = max3f(ta, S[10], S[11]); tb = max3f(tb, S[12], S[13]); ta = max3f(ta, S[14], S[15]);
    const float tm = max3f(ta, tb, m);
    const float mn = max3f(tm, __shfl_xor(tm, 32), tm);
    const float alpha = __builtin_amdgcn_exp2f(m - mn);
    if (__any(alpha != 1.0f)) {
#pragma unroll
        for (int d = 0; d < DVT; ++d) O[d] = O[d] * alpha;
    }
    float s = 0.f;
#pragma unroll
    for (int r = 0; r < 16; ++r) { S[r] = __builtin_amdgcn_exp2f(S[r] - mn); s += S[r]; }
    l = l * alpha + s; m = mn;
    u32x4 w0, w1;
    w0.x = cvt_pk_bf16(S[0], S[1]); w0.y = cvt_pk_bf16(S[2], S[3]); w0.z = cvt_pk_bf16(S[4], S[5]); w0.w = cvt_pk_bf16(S[6], S[7]);
    w1.x = cvt_pk_bf16(S[8], S[9]); w1.y = cvt_pk_bf16(S[10], S[11]); w1.z = cvt_pk_bf16(S[12], S[13]); w1.w = cvt_pk_bf16(S[14], S[15]);
    pb0 = __builtin_bit_cast(bf16x8, w0); pb1 = __builtin_bit_cast(bf16x8, w1);
}
__device__ __forceinline__ void dma_rows8(const bf16_t* src, size_t pitch, LAS unsigned char* img, int row0, int lane) {
    const int r = row0 + (lane >> 3), c = (lane & 7) ^ ((r >> 1) & 7);
    __builtin_amdgcn_global_load_lds((const GAS unsigned*)(src + (size_t)(lane >> 3) * pitch + c * 8), (LAS unsigned*)(img + row0 * 128), 16, 0, 0);
}
#define ATT_WAIT_BAR() do { asm volatile("s_waitcnt vmcnt(0) lgkmcnt(0)" ::: "memory"); __builtin_amdgcn_s_barrier(); asm volatile("" ::: "memory"); } while (0)

__device__ __forceinline__ void diff_attn_block(LAS unsigned char* lds, const bf16_t* QA, const bf16_t* KA, const bf16_t* VAT, bf16_t* CAT, const float* subln_g, float lam, int b, int h, int qb, int wave, int lane) {
    const int r32 = lane & 31, hi = lane >> 5, q0 = qb * 256 + wave * 32;
    const bf16_t* q0p = QA + ((size_t)((b * 4 + h) * 2) * SEQ + q0 + r32) * 64 + 8 * hi;
    const bf16_t* q1p = q0p + (size_t)SEQ * 64;
    LAS unsigned char* qlds = lds + 65536 + wave * 8192 + lane * 16;
#pragma unroll
    for (int ds = 0; ds < 4; ++ds) { *(LAS bf16x8*)(qlds + ds * 1024) = *(const bf16x8*)(q0p + 16 * ds); *(LAS bf16x8*)(qlds + 4096 + ds * 1024) = *(const bf16x8*)(q1p + 16 * ds); }
    const bf16_t* k0g = KA + (size_t)((b * 4 + h) * 2) * KEYS * 64 + (size_t)(8 * wave) * 64;
    const bf16_t* vtg = VAT + ((size_t)((b * 4 + h) * 128) + 16 * wave) * KEYS;
    const int fx = ((r32 >> 1) & 7) << 4;
    const int koff = r32 * 128, voff = 16384 + r32 * 128;
#define DIFF_STAGE(t, buf) do { LAS unsigned char* sb_ = lds + (buf) * 32768; const size_t k_ = (size_t)(t) * 64; \
        dma_rows8(k0g + k_ * 64, 64, sb_, 8 * wave, lane); dma_rows8(k0g + (size_t)KEYS * 64 + k_ * 64, 64, sb_ + 8192, 8 * wave, lane); \
        dma_rows8(vtg + k_, KEYS, sb_ + 16384, 16 * wave, lane); dma_rows8(vtg + (size_t)8 * KEYS + k_, KEYS, sb_ + 16384, 16 * wave + 8, lane); } while (0)
    f32x16 O0[4], O1[4];
#pragma unroll
    for (int d = 0; d < 4; ++d)
#pragma unroll
        for (int r = 0; r < 16; ++r) { O0[d][r] = 0.f; O1[d][r] = 0.f; }
    float m0 = -1e30f, m1 = -1e30f, l0 = 0.f, l1 = 0.f;
    DIFF_STAGE(0, 0);
    constexpr int NT = KEYS / 64;
    for (int t = 0; t < NT; ++t) {
        ATT_WAIT_BAR();
#if !ATT_SERIAL
        if (t + 1 < NT) DIFF_STAGE(t + 1, (t + 1) & 1);
#endif
        const LAS unsigned char* sb = lds + (t & 1) * 32768;
#if ATT_STAGGER
        if (wave >= 4) __builtin_amdgcn_s_sleep(ATT_STAGGER);
#endif
#pragma unroll 1
        for (int st = 0; st < 2; ++st) {
            bf16x8 pa0, pa1, pb0, pb1;
            f32x16 S0 = {0.f, 0.f, 0.f, 0.f, 0.f, 0.f, 0.f, 0.f, 0.f, 0.f, 0.f, 0.f, 0.f, 0.f, 0.f, 0.f}, S1 = S0;
            const LAS unsigned char* kb_ = sb + koff + st * 4096; const LAS unsigned char* vb_ = sb + voff;
#define KQ_LOAD(ds_, k0, q0, k1, q1) do { k0 = *(const LAS bf16x8*)(kb_ + (((2 * (ds_) + hi) << 4) ^ fx)); q0 = *(const LAS bf16x8*)(qlds + (ds_) * 1024); \
                k1 = *(const LAS bf16x8*)(kb_ + 8192 + (((2 * (ds_) + hi) << 4) ^ fx)); q1 = *(const LAS bf16x8*)(qlds + 4096 + (ds_) * 1024); __builtin_amdgcn_sched_barrier(0); } while (0)
#define V_LOAD(d_, v0, v1) do { v0 = *(const LAS bf16x8*)(vb_ + (d_) * 4096 + (((4 * st + hi) << 4) ^ fx)); v1 = *(const LAS bf16x8*)(vb_ + (d_) * 4096 + (((4 * st + 2 + hi) << 4) ^ fx)); __builtin_amdgcn_sched_barrier(0); } while (0)
            {
                bf16x8 ak0, aq0, ak1, aq1, bk0, bq0, bk1, bq1;
                KQ_LOAD(0, ak0, aq0, ak1, aq1);
                KQ_LOAD(1, bk0, bq0, bk1, bq1);
                S0 = __builtin_amdgcn_mfma_f32_32x32x16_bf16(ak0, aq0, S0, 0, 0, 0); S1 = __builtin_amdgcn_mfma_f32_32x32x16_bf16(ak1, aq1, S1, 0, 0, 0);
            __builtin_amdgcn_sched_barrier(0);
                KQ_LOAD(2, ak0, aq0, ak1, aq1);
                S0 = __builtin_amdgcn_mfma_f32_32x32x16_bf16(bk0, bq0, S0, 0, 0, 0); S1 = __builtin_amdgcn_mfma_f32_32x32x16_bf16(bk1, bq1, S1, 0, 0, 0);
            __builtin_amdgcn_sched_barrier(0);
                KQ_LOAD(3, bk0, bq0, bk1, bq1);
                S0 = __builtin_amdgcn_mfma_f32_32x32x16_bf16(ak0, aq0, S0, 0, 0, 0); S1 = __builtin_amdgcn_mfma_f32_32x32x16_bf16(ak1, aq1, S1, 0, 0, 0);
            __builtin_amdgcn_sched_barrier(0);
                S0 = __builtin_amdgcn_mfma_f32_32x32x16_bf16(bk0, bq0, S0, 0, 0, 0); S1 = __builtin_amdgcn_mfma_f32_32x32x16_bf16(bk1, bq1, S1, 0, 0, 0);
            __builtin_amdgcn_sched_barrier(0);
            }
            bf16x8 va0, va1, vb0, vb1;
            V_LOAD(0, va0, va1);
            softmax_step<4>(S0, m0, l0, O0, pa0, pa1);
            V_LOAD(1, vb0, vb1);
            O0[0] = __builtin_amdgcn_mfma_f32_32x32x16_bf16(va0, pa0, O0[0], 0, 0, 0); O0[0] = __builtin_amdgcn_mfma_f32_32x32x16_bf16(va1, pa1, O0[0], 0, 0, 0);
            __builtin_amdgcn_sched_barrier(0);
            V_LOAD(2, va0, va1);
            O0[1] = __builtin_amdgcn_mfma_f32_32x32x16_bf16(vb0, pa0, O0[1], 0, 0, 0); O0[1] = __builtin_amdgcn_mfma_f32_32x32x16_bf16(vb1, pa1, O0[1], 0, 0, 0);
            __builtin_amdgcn_sched_barrier(0);
            V_LOAD(3, vb0, vb1);
            O0[2] = __builtin_amdgcn_mfma_f32_32x32x16_bf16(va0, pa0, O0[2], 0, 0, 0); O0[2] = __builtin_amdgcn_mfma_f32_32x32x16_bf16(va1, pa1, O0[2], 0, 0, 0);
            __builtin_amdgcn_sched_barrier(0);
            V_LOAD(0, va0, va1);
            O0[3] = __builtin_amdgcn_mfma_f32_32x32x16_bf16(vb0, pa0, O0[3], 0, 0, 0); O0[3] = __builtin_amdgcn_mfma_f32_32x32x16_bf16(vb1, pa1, O0[3], 0, 0, 0);
            __builtin_amdgcn_sched_barrier(0);
            softmax_step<4>(S1, m1, l1, O1, pb0, pb1);
            V_LOAD(1, vb0, vb1);
            O1[0] = __builtin_amdgcn_mfma_f32_32x32x16_bf16(va0, pb0, O1[0], 0, 0, 0); O1[0] = __builtin_amdgcn_mfma_f32_32x32x16_bf16(va1, pb1, O1[0], 0, 0, 0);
            __builtin_amdgcn_sched_barrier(0);
            V_LOAD(2, va0, va1);
            O1[1] = __builtin_amdgcn_mfma_f32_32x32x16_bf16(vb0, pb0, O1[1], 0, 0, 0); O1[1] = __builtin_amdgcn_mfma_f32_32x32x16_bf16(vb1, pb1, O1[1], 0, 0, 0);
            __builtin_amdgcn_sched_barrier(0);
            V_LOAD(3, vb0, vb1);
            O1[2] = __builtin_amdgcn_mfma_f32_32x32x16_bf16(va0, pb0, O1[2], 0, 0, 0); O1[2] = __builtin_amdgcn_mfma_f32_32x32x16_bf16(va1, pb1, O1[2], 0, 0, 0);
            __builtin_amdgcn_sched_barrier(0);
            O1[3] = __builtin_amdgcn_mfma_f32_32x32x16_bf16(vb0, pb0, O1[3], 0, 0, 0); O1[3] = __builtin_amdgcn_mfma_f32_32x32x16_bf16(vb1, pb1, O1[3], 0, 0, 0);
            __builtin_amdgcn_sched_barrier(0);
#undef KQ_LOAD
#undef V_LOAD
        }
#if ATT_SERIAL
        ATT_WAIT_BAR();
        if (t + 1 < NT) DIFF_STAGE(t + 1, (t + 1) & 1);
#endif
    }
#undef DIFF_STAGE
    l0 += __shfl_xor(l0, 32); l1 += __shfl_xor(l1, 32);
    const float i0 = 1.0f / l0, i1 = lam / l1;
    float ss = 0.f;
#pragma unroll
    for (int d = 0; d < 4; ++d)
#pragma unroll
        for (int r = 0; r < 16; ++r) { const float o = O0[d][r] * i0 - O1[d][r] * i1; O0[d][r] = o; ss += o * o; }
    ss += __shfl_xor(ss, 32);
    const float rn = 0.8f / sqrtf(ss * (1.0f / 128.0f) + LN_EPS);
    bf16_t* orow = CAT + (size_t)(b * SEQ + q0 + r32) * DM + h * 128 + 4 * hi;
#pragma unroll
    for (int d = 0; d < 4; ++d)
#pragma unroll
        for (int g = 0; g < 4; ++g) {
            const int e = d * 32 + 8 * g;
            const f32x4 gg = *(const f32x4*)(subln_g + e + 4 * hi);
            u32x2 w; w.x = cvt_pk_bf16(O0[d][4 * g] * rn * gg[0], O0[d][4 * g + 1] * rn * gg[1]); w.y = cvt_pk_bf16(O0[d][4 * g + 2] * rn * gg[2], O0[d][4 * g + 3] * rn * gg[3]);
            *(u32x2*)(orow + e) = w;
        }
    ATT_WAIT_BAR();
}

__device__ __forceinline__ void win_attn_block(LAS unsigned char* lds, const bf16_t* QW, const bf16_t* KW, const bf16_t* VWT, bf16_t* CAT, const float* sink, int b, int hkv, int qblk, int wave, int lane) {
    const int r32 = lane & 31, hi = lane >> 5, hq = hkv * 4 + (wave >> 1), q0 = qblk * 64 + (wave & 1) * 32;
    const bf16_t* qp = QW + ((size_t)(b * 8 + hq) * SEQ + q0 + r32) * 64 + 8 * hi;
    bf16x8 qf[4];
#pragma unroll
    for (int ds = 0; ds < 4; ++ds) qf[ds] = *(const bf16x8*)(qp + 16 * ds);
    const bf16_t* kg = KW + (size_t)(b * 2 + hkv) * KEYS * 64 + (size_t)(8 * wave) * 64;
    const bf16_t* vtg = VWT + ((size_t)((b * 2 + hkv) * 64) + 8 * wave) * KEYS;
    const int fx = ((r32 >> 1) & 7) << 4;
    const int koff = r32 * 128, voff = 8192 + r32 * 128;
    const int jl0 = qblk - 2, jl = jl0 > 0 ? jl0 : 0, jh = (qblk + 2 < 31) ? qblk + 2 : 31, nloc = jh - jl + 1, NT = nloc + 4;
#define WIN_KEY0(i) (((i) < nloc) ? (jl + (i)) * 64 : SEQ + ((i) - nloc) * 64)
#define WIN_STAGE(i, buf) do { LAS unsigned char* sb_ = lds + (buf) * 16384; const size_t k_ = (size_t)WIN_KEY0(i); \
        dma_rows8(kg + k_ * 64, 64, sb_, 8 * wave, lane); dma_rows8(vtg + k_, KEYS, sb_ + 8192, 8 * wave, lane); } while (0)
    f32x16 O[2];
#pragma unroll
    for (int d = 0; d < 2; ++d)
#pragma unroll
        for (int r = 0; r < 16; ++r) O[d][r] = 0.f;
    float m = sink[hq] * LOG2E, l = (hi == 0) ? 1.0f : 0.f;
    const int tq = q0 + r32;
    WIN_STAGE(0, 0);
    for (int i = 0; i < NT; ++i) {
        ATT_WAIT_BAR();
#if !ATT_SERIAL
        if (i + 1 < NT) WIN_STAGE(i + 1, (i + 1) & 1);
#endif
        const LAS unsigned char* sb = lds + (i & 1) * 16384;
        const bool local = i < nloc; const int key0 = WIN_KEY0(i);
#pragma unroll
        for (int st = 0; st < 2; ++st) {
            const int kb = key0 + 32 * st;
            if (local && (kb > q0 + 31 + 128 || kb + 31 < q0 - 128)) continue;
            f32x16 S = {0.f, 0.f, 0.f, 0.f, 0.f, 0.f, 0.f, 0.f, 0.f, 0.f, 0.f, 0.f, 0.f, 0.f, 0.f, 0.f};
#pragma unroll
            for (int ds = 0; ds < 4; ++ds) S = __builtin_amdgcn_mfma_f32_32x32x16_bf16(*(const LAS bf16x8*)(sb + koff + st * 4096 + (((2 * ds + hi) << 4) ^ fx)), qf[ds], S, 0, 0, 0);
            if (local) {
#pragma unroll
                for (int r = 0; r < 16; ++r) { const int dk = kb + crow(r, hi) - tq; if (dk > 128 || dk < -128) S[r] = -1e30f; }
            }
            bf16x8 pa0, pa1;
            softmax_step<2>(S, m, l, O, pa0, pa1);
#pragma unroll
            for (int d = 0; d < 2; ++d) {
                const bf16x8 v0 = *(const LAS bf16x8*)(sb + voff + d * 4096 + (((4 * st + hi) << 4) ^ fx)), v1 = *(const LAS bf16x8*)(sb + voff + d * 4096 + (((4 * st + 2 + hi) << 4) ^ fx));
                O[d] = __builtin_amdgcn_mfma_f32_32x32x16_bf16(v0, pa0, O[d], 0, 0, 0);
                O[d] = __builtin_amdgcn_mfma_f32_32x32x16_bf16(v1, pa1, O[d], 0, 0, 0);
            }
        }
#if ATT_SERIAL
        ATT_WAIT_BAR();
        if (i + 1 < NT) WIN_STAGE(i + 1, (i + 1) & 1);
#endif
    }
#undef WIN_STAGE
#undef WIN_KEY0
    l += __shfl_xor(l, 32);
    const float il = 1.0f / l;
    bf16_t* orow = CAT + (size_t)(b * SEQ + q0 + r32) * DM + 512 + hq * 64 + 4 * hi;
#pragma unroll
    for (int d = 0; d < 2; ++d)
#pragma unroll
        for (int g = 0; g < 4; ++g) {
            u32x2 w; w.x = cvt_pk_bf16(O[d][4 * g] * il, O[d][4 * g + 1] * il); w.y = cvt_pk_bf16(O[d][4 * g + 2] * il, O[d][4 * g + 3] * il);
            *(u32x2*)(orow + d * 32 + 8 * g) = w;
        }
    ATT_WAIT_BAR();
}

__device__ __forceinline__ void transpose64(const float* W, int ldw, int k0, int csrc, bf16_t* WT, int drow, LAS float* scr, int lane) {
#pragma unroll 4
    for (int i = 0; i < 16; ++i) {
        const int kk = (lane >> 4) + 4 * i;
        const f32x4 v = *(const f32x4*)(W + (size_t)(k0 + kk) * ldw + csrc + 4 * (lane & 15));
        LAS float* s = scr + kk * 65 + 4 * (lane & 15);
        s[0] = v[0]; s[1] = v[1]; s[2] = v[2]; s[3] = v[3];
    }
    LDS_WAIT(); asm volatile("" ::: "memory");
    const int c = lane & 7;
#pragma unroll
    for (int j = 0; j < 8; ++j) {
        const int n = (lane >> 3) + 8 * j; const LAS float* s = scr + (8 * c) * 65 + n;
        u32x4 o; o.x = pk2(s[0 * 65], s[1 * 65]); o.y = pk2(s[2 * 65], s[3 * 65]); o.z = pk2(s[4 * 65], s[5 * 65]); o.w = pk2(s[6 * 65], s[7 * 65]);
        *(u32x4*)(WT + (size_t)(drow + n) * 1024 + k0 + 8 * c) = o;
    }
    LDS_WAIT(); asm volatile("" ::: "memory");
}
__device__ __forceinline__ int wqk_srccol(int r) {
    if (r >= 1664) return -1;
    const int p = r & 63, d = (p >> 1) + 32 * (p & 1);
    return (r >> 6) * 64 + d + (r >= 1536 ? 512 : 0);
}
__device__ __forceinline__ void transpose64_wqk(const float* W, int k0, bf16_t* WT, int drow, LAS float* scr, int lane) {
    const int sc = wqk_srccol(drow + lane);
#pragma unroll 8
    for (int i = 0; i < 64; ++i) scr[i * 65 + lane] = (sc >= 0) ? W[(size_t)(k0 + i) * 2304 + sc] : 0.f;
    LDS_WAIT(); asm volatile("" ::: "memory");
    const int c = lane & 7;
#pragma unroll
    for (int j = 0; j < 8; ++j) {
        const int n = (lane >> 3) + 8 * j; const LAS float* s = scr + (8 * c) * 65 + n;
        u32x4 o; o.x = pk2(s[0 * 65], s[1 * 65]); o.y = pk2(s[2 * 65], s[3 * 65]); o.z = pk2(s[4 * 65], s[5 * 65]); o.w = pk2(s[6 * 65], s[7 * 65]);
        *(u32x4*)(WT + (size_t)(drow + n) * 1024 + k0 + 8 * c) = o;
    }
    LDS_WAIT(); asm volatile("" ::: "memory");
}

struct In {
    const float *x, *c, *ctx, *c_ctx, *mod_w, *mod_b, *ln_g, *ln_b, *attn_w_in, *attn_lambda, *attn_subln_g, *attn_sink, *attn_w_out,
        *hy_w_in, *hy_conv_w, *hy_conv_b, *hy_ffn_w_in, *hy_ffn_w_hid, *hy_ffn_b, *hy_sin_freq, *hy_ffn_w_out, *hy_skip, *hy_w_out,
        *router_w, *router_bias, *exp_w_gate, *exp_w_up, *exp_w_down;
};

struct TrItem { const float* src; bf16_t* dst; };
__device__ __forceinline__ TrItem expert_item(const In& I, unsigned char* ws, int it) {
    const int l = it / (16 * 768), item = it % (16 * 768);
    const int e = item / 768, r = item % 768, which = r >> 8, q = r & 255, kt = q >> 4, ci = q & 15;
    const size_t eoff = ((size_t)l * NEXP + e) * 1024 * 1024;
    TrItem t;
    if (which == 2) { t.src = I.exp_w_down + eoff + (size_t)(kt * 64) * 1024 + ci * 64; t.dst = (bf16_t*)(ws + WS_WD) + eoff + (size_t)(ci * 64) * 1024 + kt * 64; }
    else { t.src = (which == 0 ? I.exp_w_gate : I.exp_w_up) + eoff + (size_t)(kt * 64) * 1024 + ci * 64;
           t.dst = (bf16_t*)(ws + WS_WGU) + eoff * 2 + (size_t)((ci >> 1) * 256 + which * 128 + (ci & 1) * 64) * 1024 + kt * 64; }
    return t;
}
__device__ __forceinline__ void tr_load(const TrItem& t, f32x4 (&v)[16], int lane) {
#pragma unroll
    for (int i = 0; i < 16; ++i) v[i] = __builtin_nontemporal_load((const f32x4*)(t.src + (size_t)((lane >> 4) + 4 * i) * 1024 + 4 * (lane & 15)));
}
__device__ __forceinline__ void tr_store(const TrItem& t, const f32x4 (&v)[16], LAS float* scr, int lane) {
#pragma unroll
    for (int i = 0; i < 16; ++i) { LAS float* s = scr + ((lane >> 4) + 4 * i) * 65 + 4 * (lane & 15); s[0] = v[i][0]; s[1] = v[i][1]; s[2] = v[i][2]; s[3] = v[i][3]; }
    LDS_WAIT(); asm volatile("" ::: "memory");
    const int c = lane & 7;
#pragma unroll
    for (int j = 0; j < 8; ++j) {
        const int n = (lane >> 3) + 8 * j; const LAS float* s = scr + (8 * c) * 65 + n;
        u32x4 o; o.x = pk2(s[0 * 65], s[1 * 65]); o.y = pk2(s[2 * 65], s[3 * 65]); o.z = pk2(s[4 * 65], s[5 * 65]); o.w = pk2(s[6 * 65], s[7 * 65]);
        __builtin_nontemporal_store(o, (u32x4*)(t.dst + (size_t)n * 1024 + 8 * c));
    }
    LDS_WAIT(); asm volatile("" ::: "memory");
}

__device__ __forceinline__ void drain_convert_queue(const In& I, unsigned char* ws, LAS unsigned char* lds, int wave, int lane, int quota) {
    unsigned* head = (unsigned*)(ws + WS_CTL) + CW_Q1;
    LAS float* scr = (LAS float*)(lds + wave * 16640);
    for (int n = 0; n < quota; ++n) {
        unsigned it = 0u;
        if (lane == 0) it = atomicAdd(head, 1u);
        it = (unsigned)__builtin_amdgcn_readfirstlane((int)it);
        if (it >= 16u * 768u) break;
        const TrItem t = expert_item(I, ws, 16 * 768 + (int)it);
        f32x4 v[16];
        tr_load(t, v, lane); tr_store(t, v, scr, lane);
    }
}
__device__ __forceinline__ int idle_quota(int U, int bid, int G, int per_round) {
    const int maxu = (U + G - 1) / G, mine = (bid < U) ? (U - bid + G - 1) / G : 0;
    return (maxu - mine) * per_round;
}

__device__ __forceinline__ void phase_prep(const In& I, unsigned char* ws, LAS unsigned char* lds, int tid, int lane, int wave, int bid, int G) {
    if (bid < 96) {
        LAS float* sl = (LAS float*)lds;
        LAS float* part = (LAS float*)(lds + 36864);
        for (int i = tid; i < 9 * 1024; i += 512) { const float v = (i < 8192) ? I.c[i] : I.c_ctx[i - 8192]; sl[i] = v / (1.0f + expf(-v)); }
        __syncthreads();
        const int l = bid / 48, cgp = bid % 48, cgi = tid & 31, ks = tid >> 5, col = cgp * 128 + 4 * cgi;
        f32x4 acc[9];
#pragma unroll
        for (int r = 0; r < 9; ++r) acc[r] = (f32x4){0.f, 0.f, 0.f, 0.f};
#pragma unroll 2
        for (int kk = 0; kk < 64; ++kk) {
            const int k = ks * 64 + kk;
            const f32x4 w = *(const f32x4*)(I.mod_w + ((size_t)l * 1024 + k) * 6144 + col);
#pragma unroll
            for (int r = 0; r < 9; ++r) acc[r] += w * sl[r * 1024 + k];
        }
#pragma unroll
        for (int r = 0; r < 9; ++r) { LAS float* p = part + (ks * 9 + r) * 128 + 4 * cgi; p[0] = acc[r][0]; p[1] = acc[r][1]; p[2] = acc[r][2]; p[3] = acc[r][3]; }
        __syncthreads();
        float* MOD = (float*)(ws + WS_MOD);
        for (int idx = tid; idx < 9 * 128; idx += 512) {
            const int r = idx >> 7, cc = idx & 127; float s = I.mod_b[l * 6144 + cgp * 128 + cc];
#pragma unroll
            for (int k2 = 0; k2 < 16; ++k2) s += part[(k2 * 9 + r) * 128 + cc];
            MOD[(size_t)(l * 9 + r) * 6144 + cgp * 128 + cc] = s;
        }
        __syncthreads();
    }
    for (int item = bid; item < 256; item += G) {
        LAS float* z = (LAS float*)lds;
        LAS float* h1 = z + 8 * 33;
        LAS float* h2 = h1 + 512;
        LAS float* h3 = h2 + 512;
        const int pos0 = item * 8;
        if (tid < 8 * 33) {
            const int p = tid / 33, f = tid % 33, pos = pos0 + p;
            const float tt = (float)pos / 2047.0f, w = 6.283185307179586f * (float)pos / 2048.0f;
            float v;
            if (f == 0) v = tt;
            else { const int bi = (f - 1) & 15; const float fr = 1e-4f + (float)bi * ((15.0f - 1e-4f) / 15.0f); v = (f <= 16) ? cosf(fr * w) : -sinf(fr * w); }
            z[p * 33 + f] = v;
        }
        __syncthreads();
        const int p = tid >> 6, j = tid & 63;
        { float a = I.hy_ffn_b[j];
_Pragma("unroll 4")
          for (int f = 0; f < 33; ++f) a += z[p * 33 + f] * I.hy_ffn_w_in[f * 64 + j];
          h1[p * 64 + j] = sinf(I.hy_sin_freq[j] * a); }
        __syncthreads();
        { float a = I.hy_ffn_b[64 + j];
_Pragma("unroll 4")
          for (int f = 0; f < 64; ++f) a += h1[p * 64 + f] * I.hy_ffn_w_hid[f * 64 + j];
          h2[p * 64 + j] = sinf(I.hy_sin_freq[64 + j] * a); }
        __syncthreads();
        { float a = I.hy_ffn_b[128 + j];
_Pragma("unroll 4")
          for (int f = 0; f < 64; ++f) a += h2[p * 64 + f] * I.hy_ffn_w_hid[4096 + f * 64 + j];
          h3[p * 64 + j] = sinf(I.hy_sin_freq[128 + j] * a); }
        __syncthreads();
        const int col = tid * 8;
        f32x4 a0[8], a1[8];
#pragma unroll
        for (int q = 0; q < 8; ++q) { a0[q] = (f32x4){0.f, 0.f, 0.f, 0.f}; a1[q] = (f32x4){0.f, 0.f, 0.f, 0.f}; }
#pragma unroll 2
        for (int k = 0; k < 64; ++k) {
            const f32x4 w0 = *(const f32x4*)(I.hy_ffn_w_out + (size_t)k * 4096 + col), w1 = *(const f32x4*)(I.hy_ffn_w_out + (size_t)k * 4096 + col + 4);
#pragma unroll
            for (int q = 0; q < 8; ++q) { const float hv = h3[q * 64 + k]; a0[q] += w0 * hv; a1[q] += w1 * hv; }
        }
        bf16_t* KREV = (bf16_t*)(ws + WS_KFB);
#pragma unroll
        for (int cc = 0; cc < 8; ++cc) {
            const int colq = col + cc, dir = colq >> 11, o = (colq >> 10) & 1, ch = colq & 1023;
            const float delta = fabsf(-3.0701134573253944f + (float)ch * ((-15.350567286626972f + 3.0701134573253944f) / 1023.0f));
            float v[8];
#pragma unroll
            for (int q = 0; q < 8; ++q) { const float tt = (float)(pos0 + q) / 2047.0f; const float a = (cc < 4) ? a0[q][cc & 3] : a1[q][cc & 3]; v[q] = a * expf(-tt * delta); }
            bf16_t* row = KREV + ((size_t)(o * 1024 + ch)) * 4096;
            if (dir == 0) {
                u32x4 wv; wv.x = pk2(v[7], v[6]); wv.y = pk2(v[5], v[4]); wv.z = pk2(v[3], v[2]); wv.w = pk2(v[1], v[0]);
                *(u32x4*)(row + 2040 - pos0) = wv;
            } else {
#pragma unroll
                for (int q = 0; q < 8; ++q) if (pos0 + q >= 1) row[2047 + pos0 + q] = (bf16_t)f2bf(v[q]);
                if (pos0 == 0) row[4095] = 0;
            }
        }
        __syncthreads();
    }
    {
        const int gt = bid * 512 + tid, NT = G * 512;
        float* rope = (float*)(ws + WS_ROPE);
        for (int i = gt; i < 2048 * 32; i += NT) {
            const int t = i >> 5, dd = i & 31; const int pidx = (dd < 16) ? (t >> 6) : (t & 63); const int fi = dd & 15;
            const float inv = powf(10000.0f, -(float)(2 * fi) / 32.0f); const float ang = (float)pidx * inv;
            rope[2 * i] = cosf(ang); rope[2 * i + 1] = sinf(ang);
        }
        unsigned* wvpad = (unsigned*)((bf16_t*)(ws + WS_WV) + 640 * 1024);
        for (int i = gt; i < 128 * 1024 / 2; i += NT) wvpad[i] = 0u;
    }
    {
        LAS float* scr = (LAS float*)(lds + wave * 16640);
        const int gw = bid * 8 + wave, NGW = G * 8;
        constexpr int I_QK = 16 * 28, I_V = 16 * 10, I_O = 256, I_HI = 16 * 48, I_HO = 256, I_SMALL = I_QK + I_V + I_O + I_HI + I_HO;
        for (int it = gw; it < I_SMALL; it += NGW) {
            int r = it;
            if (r < I_QK) { transpose64_wqk(I.attn_w_in, (r / 28) * 64, (bf16_t*)(ws + WS_WQK), (r % 28) * 64, scr, lane); continue; } r -= I_QK;
            if (r < I_V) { const int ct = r % 10, kt = r / 10; transpose64(I.attn_w_in, 2304, kt * 64, (ct < 8) ? 1536 + ct * 64 : 2176 + (ct - 8) * 64, (bf16_t*)(ws + WS_WV), ct * 64, scr, lane); continue; } r -= I_V;
            if (r < I_O) { transpose64(I.attn_w_out, 1024, (r >> 4) * 64, (r & 15) * 64, (bf16_t*)(ws + WS_WO), (r & 15) * 64, scr, lane); continue; } r -= I_O;
            if (r < I_HI) { transpose64(I.hy_w_in, 3072, (r / 48) * 64, (r % 48) * 64, (bf16_t*)(ws + WS_HIN), (r % 48) * 64, scr, lane); continue; } r -= I_HI;
            transpose64(I.hy_w_out, 1024, (r >> 4) * 64, (r & 15) * 64, (bf16_t*)(ws + WS_HOUT), (r & 15) * 64, scr, lane);
        }
        {
            constexpr int NIT = 2 * 16 * 768;
            f32x4 va[16], vb[16];
            int it = gw;
            TrItem ta = expert_item(I, ws, it), tb = ta;
            tr_load(ta, va, lane);
            while (it < NIT) {
                const int itn = it + NGW;
                if (itn < NIT) { tb = expert_item(I, ws, itn); tr_load(tb, vb, lane); }
                tr_store(ta, va, scr, lane);
                it = itn; if (it >= NIT) break;
                const int itn2 = it + NGW;
                if (itn2 < NIT) { ta = expert_item(I, ws, itn2); tr_load(ta, va, lane); }
                tr_store(tb, vb, scr, lane);
                it = itn2;
            }
        }
    }
}

__device__ __forceinline__ void phase_modulate0(const In& I, unsigned char* ws, int lane, int gw, int NGW) {
    const float* MOD = (const float*)(ws + WS_MOD);
    bf16_t* HA = (bf16_t*)(ws + WS_HA); bf16_t* HC = (bf16_t*)(ws + WS_Y);
    for (int row = gw; row < TOK + CTOK; row += NGW) {
        const float* src; const float* mv; bf16_t* dst;
        if (row < TOK) { src = I.x + (size_t)row * DM; mv = MOD + (size_t)(row >> 11) * 6144; dst = HA + (size_t)row * DM; }
        else { const int r2 = row - TOK; src = I.ctx + (size_t)r2 * DM; mv = MOD + (size_t)8 * 6144; dst = HC + (size_t)r2 * DM; }
#pragma unroll
        for (int j = 0; j < 4; ++j) {
            const int d = 4 * (lane + 64 * j);
            const f32x4 v = *(const f32x4*)(src + d), sh = *(const f32x4*)(mv + d), sc = *(const f32x4*)(mv + 1024 + d);
            const f32x4 h = v * (sc + 1.0f) + sh;
            u32x2 w; w.x = pk2(h[0], h[1]); w.y = pk2(h[2], h[3]);
            *(u32x2*)(dst + d) = w;
        }
    }
}

__device__ __forceinline__ void phase_ln1_router(const In& I, unsigned char* ws, LAS unsigned char* lds, int l, int tid, int lane, int wave, int gw, int NGW) {
    LAS float* wT = (LAS float*)lds;
    for (int i = tid; i < 16384; i += 512) { const int d = i >> 4, e = i & 15; wT[e * 1024 + d] = I.router_w[i]; }
    const float* MOD = (const float*)(ws + WS_MOD) + (size_t)l * 9 * 6144;
    const bf16_t* Y = (const bf16_t*)(ws + WS_Y);
    bf16_t* XR = (bf16_t*)(ws + WS_XR); bf16_t* HA = (bf16_t*)(ws + WS_HA);
    int* slot_tok = (int*)(ws + WS_SLOT); float* slot_w = (float*)(ws + WS_SLOT + MiB);
    int* cnt = (int*)(ws + WS_CTL) + CW_CNT + l * 16 * 64;
    LAS int* lcnt = (LAS int*)(lds + 65536);
    if (tid < 32) lcnt[tid] = 0;
    __syncthreads();
    const float* lg = I.ln_g + (size_t)(l * 2) * DM; const float* lb = I.ln_b + (size_t)(l * 2) * DM;
    float rbias[16];
#pragma unroll
    for (int e = 0; e < 16; ++e) rbias[e] = I.router_bias[e];
    for (int r0 = gw * 8; r0 < TOK; r0 += NGW * 8) {
        const float* mv = MOD + (size_t)(r0 >> 11) * 6144;
        f32x4 g1v[4], lgv[4], lbv[4], scv[4], shv[4];
#pragma unroll
        for (int j = 0; j < 4; ++j) { const int d = 4 * (lane + 64 * j); g1v[j] = *(const f32x4*)(mv + 2048 + d); lgv[j] = *(const f32x4*)(lg + d); lbv[j] = *(const f32x4*)(lb + d); scv[j] = *(const f32x4*)(mv + 4096 + d) + 1.0f; shv[j] = *(const f32x4*)(mv + 3072 + d); }
#pragma unroll 2
        for (int ri = 0; ri < 8; ++ri) {
            const int row = r0 + ri;
            f32x4 v[4]; float s = 0.f;
#pragma unroll
            for (int j = 0; j < 4; ++j) {
                const int d = 4 * (lane + 64 * j);
                f32x4 xv;
                if (l == 0) xv = *(const f32x4*)(I.x + (size_t)row * DM + d);
                else { const u32x2 xw = *(const u32x2*)(XR + (size_t)row * DM + d); xv = (f32x4){bflo(xw.x), bfhi(xw.x), bflo(xw.y), bfhi(xw.y)}; }
                const u32x2 yw = *(const u32x2*)(Y + (size_t)row * DM + d);
                const f32x4 yv = (f32x4){bflo(yw.x), bfhi(yw.x), bflo(yw.y), bfhi(yw.y)};
                v[j] = xv * DN_ALPHA + g1v[j] * yv; s += (v[j][0] + v[j][1]) + (v[j][2] + v[j][3]);
            }
            const float mean = wave_sum(s) * (1.0f / DM); float s2 = 0.f;
#pragma unroll
            for (int j = 0; j < 4; ++j) { v[j] = v[j] - mean; s2 += (v[j][0] * v[j][0] + v[j][1] * v[j][1]) + (v[j][2] * v[j][2] + v[j][3] * v[j][3]); }
            const float rstd = 1.0f / sqrtf(wave_sum(s2) * (1.0f / DM) + LN_EPS);
            float lgt[16];
#pragma unroll
            for (int e = 0; e < 16; ++e) lgt[e] = 0.f;
#pragma unroll
            for (int j = 0; j < 4; ++j) {
                const int d = 4 * (lane + 64 * j);
                const f32x4 x1 = v[j] * rstd * lgv[j] + lbv[j];
                { u32x2 xw; xw.x = pk2(x1[0], x1[1]); xw.y = pk2(x1[2], x1[3]); *(u32x2*)(XR + (size_t)row * DM + d) = xw; }
                const f32x4 h2 = x1 * scv[j] + shv[j];
                u32x2 w; w.x = pk2(h2[0], h2[1]); w.y = pk2(h2[2], h2[3]);
                *(u32x2*)(HA + (size_t)row * DM + d) = w;
#pragma unroll
                for (int e = 0; e < 16; ++e) { const f32x4 wv = *(const LAS f32x4*)(wT + e * 1024 + d); lgt[e] += (h2[0] * wv[0] + h2[1] * wv[1]) + (h2[2] * wv[2] + h2[3] * wv[3]); }
                asm volatile("" ::: "memory");
            }
            float r8[8], r4[4], r2[2], r1;
#pragma unroll
            for (int k = 0; k < 8; ++k) { const bool up = (lane & 32) != 0; const float keep = up ? lgt[k + 8] : lgt[k], send = up ? lgt[k] : lgt[k + 8]; r8[k] = keep + __shfl_xor(send, 32); }
#pragma unroll
            for (int k = 0; k < 4; ++k) { const bool up = (lane & 16) != 0; const float keep = up ? r8[k + 4] : r8[k], send = up ? r8[k] : r8[k + 4]; r4[k] = keep + __shfl_xor(send, 16); }
#pragma unroll
            for (int k = 0; k < 2; ++k) { const bool up = (lane & 8) != 0; const float keep = up ? r4[k + 2] : r4[k], send = up ? r4[k] : r4[k + 2]; r2[k] = keep + __shfl_xor(send, 8); }
            { const bool up = (lane & 4) != 0; const float keep = up ? r2[1] : r2[0], send = up ? r2[0] : r2[1]; r1 = keep + __shfl_xor(send, 4); }
            r1 += __shfl_xor(r1, 2); r1 += __shfl_xor(r1, 1);
#pragma unroll
            for (int e = 0; e < 16; ++e) lgt[e] = __shfl(r1, ((e >> 3) & 1) * 32 + ((e >> 2) & 1) * 16 + ((e >> 1) & 1) * 8 + (e & 1) * 4);
            float mx = lgt[0];
#pragma unroll
            for (int e = 1; e < 16; ++e) mx = fmaxf(mx, lgt[e]);
            float sc[16], den = 0.f;
#pragma unroll
            for (int e = 0; e < 16; ++e) { sc[e] = expf(lgt[e] - mx); den += sc[e]; }
            const float iden = 1.0f / den;
            float sel[16];
#pragma unroll
            for (int e = 0; e < 16; ++e) { sc[e] *= iden; sel[e] = sc[e] + rbias[e]; }
            float bgs = -1e30f; int e0 = 0, e1 = 0; float w0 = 0.f, w1 = 0.f;
#pragma unroll
            for (int g = 0; g < 4; ++g) {
                int i0 = 0; float v0 = sel[4 * g];
#pragma unroll
                for (int k = 1; k < 4; ++k) if (sel[4 * g + k] > v0) { v0 = sel[4 * g + k]; i0 = k; }
                int i1 = -1; float v1 = -1e30f;
#pragma unroll
                for (int k = 0; k < 4; ++k) if (k != i0 && sel[4 * g + k] > v1) { v1 = sel[4 * g + k]; i1 = k; }
                const float gs = v0 + v1;
                if (gs > bgs) {
                    bgs = gs; e0 = 4 * g + i0; e1 = 4 * g + i1;
                    float sa = 0.f, sb = 0.f;
#pragma unroll
                    for (int k = 0; k < 4; ++k) { sa = (k == i0) ? sc[4 * g + k] : sa; sb = (k == i1) ? sc[4 * g + k] : sb; }
                    w0 = sa; w1 = sb;
                }
            }
            const float wn = 1.0f / (w0 + w1);
            if (lane == 0) {
                const int p0 = __hip_atomic_fetch_add(lcnt + e0, 1, __ATOMIC_RELAXED, __HIP_MEMORY_SCOPE_WORKGROUP), p1 = __hip_atomic_fetch_add(lcnt + e1, 1, __ATOMIC_RELAXED, __HIP_MEMORY_SCOPE_WORKGROUP);
                const int li = wave * 8 + ri;
                lcnt[32 + 2 * li] = p0; lcnt[33 + 2 * li] = p1; lcnt[160 + 2 * li] = e0; lcnt[161 + 2 * li] = e1;
                ((LAS float*)lcnt)[288 + 2 * li] = w0 * wn; ((LAS float*)lcnt)[289 + 2 * li] = w1 * wn;
            }
        }
    }
    __syncthreads();
    if (tid < 16) lcnt[16 + tid] = atomicAdd(cnt + 64 * tid, lcnt[tid]);
    __syncthreads();
    for (int r0 = gw * 8; r0 < TOK; r0 += NGW * 8) {
        if (lane < 16) { const int ri = lane >> 1, k = lane & 1, li = wave * 8 + ri, e = lcnt[160 + 2 * li + k], pos = lcnt[16 + e] + lcnt[32 + 2 * li + k];
            slot_tok[e * SLOT_CAP + pos] = (r0 + ri) * 2 + k; slot_w[e * SLOT_CAP + pos] = ((LAS float*)lcnt)[288 + 2 * li + k]; }
    }
}

__device__ __forceinline__ void build_moe_tabs(unsigned char* ws, LAS unsigned char* lds, int l, int tid, int bid, int G, bool gather) {
    const int* cnt = (const int*)(ws + WS_CTL) + CW_CNT + l * 16 * 64;
    LAS int* rbtab = (LAS int*)(lds + RBTAB_OFF); LAS int* rbloc = rbtab + 160; LAS int* ecnt = rbtab + 320;
    if (tid < 160) {
        int e = -1, acc = 0, loc = 0;
        for (int i = 0; i < 16; ++i) { const int c = __hip_atomic_load(cnt + 64 * i, __ATOMIC_RELAXED, __HIP_MEMORY_SCOPE_AGENT); const int nb = (c + 255) >> 8; if (e < 0 && tid < acc + nb) { e = i; loc = tid - acc; } acc += nb; }
        rbtab[tid] = e; rbloc[tid] = loc;
    }
    if (tid < 16) ecnt[tid] = __hip_atomic_load(cnt + 64 * tid, __ATOMIC_RELAXED, __HIP_MEMORY_SCOPE_AGENT);
    if (tid == 16) { int acc = 0; for (int i = 0; i < 16; ++i) { const int c = __hip_atomic_load(cnt + 64 * i, __ATOMIC_RELAXED, __HIP_MEMORY_SCOPE_AGENT); acc += (c + 255) >> 8; } rbtab[336] = acc; }
    __syncthreads();
    if (gather) {
        const int* slot_tok = (const int*)(ws + WS_SLOT);
        LAS unsigned* gtab = (LAS unsigned*)(lds + GTAB_OFF);
        for (int idx = tid; idx < 5 * 256; idx += 512) {
            const int i = idx >> 8, r = idx & 255, rb = (i * G + bid) >> 3;
            unsigned off = 0u;
            if (rb < MAXBLK) { const int e = rbtab[rb]; if (e >= 0) { const int slot = rbloc[rb] * 256 + r; if (slot < ecnt[e]) off = (unsigned)(slot_tok[e * SLOT_CAP + slot] >> 1) * 2048u; } }
            gtab[idx] = off;
        }
        __syncthreads();
    }
}

__device__ __forceinline__ void phase_ln2(const In& I, unsigned char* ws, int l, float* out, int lane, int gw, int NGW) {
    const float* MOD = (const float*)(ws + WS_MOD);
    bf16_t* XR = (bf16_t*)(ws + WS_XR); bf16_t* HA = (bf16_t*)(ws + WS_HA); const bf16_t* F2 = (const bf16_t*)(ws + WS_R2);
    const float* lg = I.ln_g + (size_t)(l * 2 + 1) * DM; const float* lb = I.ln_b + (size_t)(l * 2 + 1) * DM;
    for (int r0 = gw * 8; r0 < TOK; r0 += NGW * 8) {
        const float* mv = MOD + (size_t)(l * 9 + (r0 >> 11)) * 6144; const float* mv1 = MOD + (size_t)(9 + (r0 >> 11)) * 6144;
        f32x4 g2v[4], lgv[4], lbv[4], scv[4], shv[4];
#pragma unroll
        for (int j = 0; j < 4; ++j) { const int d = 4 * (lane + 64 * j); g2v[j] = *(const f32x4*)(mv + 5120 + d); lgv[j] = *(const f32x4*)(lg + d); lbv[j] = *(const f32x4*)(lb + d);
            scv[j] = *(const f32x4*)(mv1 + 1024 + d) + 1.0f; shv[j] = *(const f32x4*)(mv1 + d); }
#pragma unroll 2
        for (int ri = 0; ri < 8; ++ri) {
            const int row = r0 + ri;
            f32x4 v[4]; float s = 0.f;
#pragma unroll
            for (int j = 0; j < 4; ++j) {
                const int d = 4 * (lane + 64 * j);
                const u32x2 xw = *(const u32x2*)(XR + (size_t)row * DM + d); const f32x4 xv = (f32x4){bflo(xw.x), bfhi(xw.x), bflo(xw.y), bfhi(xw.y)};
                const u32x2 fa = *(const u32x2*)(F2 + (size_t)(row * 2) * DM + d), fb = *(const u32x2*)(F2 + (size_t)(row * 2 + 1) * DM + d);
                const f32x4 fv = (f32x4){bflo(fa.x) + bflo(fb.x), bfhi(fa.x) + bfhi(fb.x), bflo(fa.y) + bflo(fb.y), bfhi(fa.y) + bfhi(fb.y)};
                v[j] = xv * DN_ALPHA + g2v[j] * fv; s += (v[j][0] + v[j][1]) + (v[j][2] + v[j][3]);
            }
            const float mean = wave_sum(s) * (1.0f / DM); float s2 = 0.f;
#pragma unroll
            for (int j = 0; j < 4; ++j) { v[j] = v[j] - mean; s2 += (v[j][0] * v[j][0] + v[j][1] * v[j][1]) + (v[j][2] * v[j][2] + v[j][3] * v[j][3]); }
            const float rstd = 1.0f / sqrtf(wave_sum(s2) * (1.0f / DM) + LN_EPS);
#pragma unroll
            for (int j = 0; j < 4; ++j) {
                const int d = 4 * (lane + 64 * j);
                const f32x4 x2 = v[j] * rstd * lgv[j] + lbv[j];
                if (l == 0) {
                    { u32x2 xw2; xw2.x = pk2(x2[0], x2[1]); xw2.y = pk2(x2[2], x2[3]); *(u32x2*)(XR + (size_t)row * DM + d) = xw2; }
                    const f32x4 h = x2 * scv[j] + shv[j];
                    u32x2 w; w.x = pk2(h[0], h[1]); w.y = pk2(h[2], h[3]);
                    *(u32x2*)(HA + (size_t)row * DM + d) = w;
                } else *(f32x4*)(out + (size_t)row * DM + d) = x2;
            }
        }
    }
}

constexpr int HY_YOFF = 2176;
constexpr int HY_ZP = 0;
constexpr int HY_RAW = 36864;
constexpr int HY_TC = 45056;
constexpr int HY_TCP = 8976;
constexpr int HY_GATE = HY_TC + 8 * HY_TCP;
static_assert(HY_GATE + 32768 <= MISC_OFF, "hyena LDS");
__device__ __forceinline__ int hy_zrow(int bb) { return HY_ZP + bb * 4624 - (bb >> 2) * 64; }
__device__ __forceinline__ int hy_tcbase(int m) { const int off = (0x035089ACu >> (4 * m)) & 15; return HY_TC + m * HY_TCP + (((off - m) & 15) << 4); }

__device__ __forceinline__ u32x4 hy_conv8(const bf16_t* urow, int t0, float w0, float w1, float w2, float bias) {
    const u32x4 v = *(const u32x4*)(urow + t0);
    float u[10];
    u[0] = (t0 > 0) ? bf2f(urow[t0 - 1]) : 0.f; u[9] = (t0 + 8 < SEQ) ? bf2f(urow[t0 + 8]) : 0.f;
    u[1] = bflo(v.x); u[2] = bfhi(v.x); u[3] = bflo(v.y); u[4] = bfhi(v.y); u[5] = bflo(v.z); u[6] = bfhi(v.z); u[7] = bflo(v.w); u[8] = bfhi(v.w);
    float o[8];
#pragma unroll
    for (int j = 0; j < 8; ++j) o[j] = u[j] * w0 + u[j + 1] * w1 + u[j + 2] * w2 + bias;
    u32x4 r; r.x = pk2(o[0], o[1]); r.y = pk2(o[2], o[3]); r.z = pk2(o[4], o[5]); r.w = pk2(o[6], o[7]);
    return r;
}
__device__ __forceinline__ void hy_build_tc(LAS unsigned char* lds, int tid) {
    const LAS unsigned* raw = (const LAS unsigned*)(lds + HY_RAW);
    for (int i = tid; i < 8 * 2180; i += 512) {
        const int m = i / 2180, w = i - m * 2180, q = 2 * w + m - 129;
        unsigned val;
        if (q & 1) {
            const int wa = (q - 1) >> 1;
            const unsigned a = (wa >= 0 && wa < 2048) ? raw[wa] : 0u, b = (wa + 1 >= 0 && wa + 1 < 2048) ? raw[wa + 1] : 0u;
            val = (a >> 16) | (b << 16);
        } else { const int wa = q >> 1; val = (wa >= 0 && wa < 2048) ? raw[wa] : 0u; }
        *(LAS unsigned*)(lds + hy_tcbase(m) + 4 * w) = val;
    }
}
__device__ __forceinline__ void hy_conv(LAS unsigned char* lds, int wave, int lane, f32x16& acc0, f32x16& acc1) {
    asm volatile("" : "+v"(lane));
    const int r32 = lane & 31, hi = lane >> 5, m = (8 - (r32 & 7)) & 7, il = r32 >> 3, bb = r32 & 7;
    const LAS unsigned char* abase = lds + hy_tcbase(m) + ((HY_YOFF - r32 - m) >> 3) * 16 + hi * 16;
    const LAS unsigned char* zbase = lds + hy_zrow(bb) + (32 * (il + 3) + 8 * hi) * 2;
#pragma unroll
    for (int r = 0; r < 16; ++r) { acc0[r] = 0.f; acc1[r] = 0.f; }
    const int G0 = 2 * wave, G1 = 2 * wave + 1;
    for (int D = 8 * wave - 63; D < 8 * wave - 59; ++D) {
        const bf16x8 a0 = *(const LAS bf16x8*)(abase + (-4 * D) * 16), a1 = *(const LAS bf16x8*)(abase + (-4 * D + 2) * 16);
        const int j0 = 4 * G0 - D;
        const bf16x8 b0 = *(const LAS bf16x8*)(zbase + (32 * j0) * 2), b1 = *(const LAS bf16x8*)(zbase + (32 * j0 + 16) * 2);
        acc0 = __builtin_amdgcn_mfma_f32_32x32x16_bf16(a0, b0, acc0, 0, 0, 0);
        acc0 = __builtin_amdgcn_mfma_f32_32x32x16_bf16(a1, b1, acc0, 0, 0, 0);
    }
    {
#define HY_LOAD(D_, a0, a1, b0, b1, c0, c1) do { const int d_ = (D_); a0 = *(const LAS bf16x8*)(abase + (-4 * d_) * 16); a1 = *(const LAS bf16x8*)(abase + (-4 * d_ + 2) * 16); \
        const int j0_ = 4 * G0 - d_; b0 = *(const LAS bf16x8*)(zbase + (32 * j0_) * 2); b1 = *(const LAS bf16x8*)(zbase + (32 * j0_ + 16) * 2); \
        c0 = *(const LAS bf16x8*)(zbase + (32 * j0_ + 128) * 2); c1 = *(const LAS bf16x8*)(zbase + (32 * j0_ + 144) * 2); } while (0)
#define HY_MMA(a0, a1, b0, b1, c0, c1) do { acc0 = __builtin_amdgcn_mfma_f32_32x32x16_bf16(a0, b0, acc0, 0, 0, 0); acc1 = __builtin_amdgcn_mfma_f32_32x32x16_bf16(a0, c0, acc1, 0, 0, 0); \
        acc0 = __builtin_amdgcn_mfma_f32_32x32x16_bf16(a1, b1, acc0, 0, 0, 0); acc1 = __builtin_amdgcn_mfma_f32_32x32x16_bf16(a1, c1, acc1, 0, 0, 0); } while (0)
        bf16x8 pa0, pa1, pb0, pb1, pc0, pc1, qa0, qa1, qb0, qb1, qc0, qc1;
        const int Ds = 8 * wave - 59;
        HY_LOAD(Ds, pa0, pa1, pb0, pb1, pc0, pc1);
        for (int D = Ds; D < Ds + 62; D += 2) {
            HY_LOAD(D + 1, qa0, qa1, qb0, qb1, qc0, qc1);
            HY_MMA(pa0, pa1, pb0, pb1, pc0, pc1);
            HY_LOAD(D + 2, pa0, pa1, pb0, pb1, pc0, pc1);
            HY_MMA(qa0, qa1, qb0, qb1, qc0, qc1);
        }
        HY_MMA(pa0, pa1, pb0, pb1, pc0, pc1);
#undef HY_LOAD
#undef HY_MMA
    }
    for (int D = 8 * wave + 4; D <= 8 * wave + 7; ++D) {
        const bf16x8 a0 = *(const LAS bf16x8*)(abase + (-4 * D) * 16), a1 = *(const LAS bf16x8*)(abase + (-4 * D + 2) * 16);
        const int j1 = 4 * G1 - D;
        const bf16x8 c0 = *(const LAS bf16x8*)(zbase + (32 * j1) * 2), c1 = *(const LAS bf16x8*)(zbase + (32 * j1 + 16) * 2);
        acc1 = __builtin_amdgcn_mfma_f32_32x32x16_bf16(a0, c0, acc1, 0, 0, 0);
        acc1 = __builtin_amdgcn_mfma_f32_32x32x16_bf16(a1, c1, acc1, 0, 0, 0);
    }
}
__device__ __forceinline__ void phase_hyena(const In& I, unsigned char* ws, LAS unsigned char* lds, int tid, int lane, int wave, int bid, int G) {
    const bf16_t* UT = (const bf16_t*)(ws + WS_BIG); const bf16_t* KREV = (const bf16_t*)(ws + WS_KFB); bf16_t* Z2T = (bf16_t*)(ws + WS_R2);
    const int r32 = lane & 31, hi = lane >> 5, il = r32 >> 3, bb = r32 & 7;
    for (int i = tid; i < 8 * 6 * 32; i += 512) { const int b = i / 192, q = i % 192, blk = q >> 5, e = q & 31; const int pos = (blk < 3 ? blk : 64 + blk) * 32 + e; *(LAS bf16_t*)(lds + hy_zrow(b) + pos * 2) = 0; }
    for (int c = bid; c < DM; c += G) {
        __syncthreads();
        {
            const float w0 = I.hy_conv_w[c], w1 = I.hy_conv_w[3072 + c], w2 = I.hy_conv_w[6144 + c], bs = I.hy_conv_b[c];
            const float x0 = I.hy_conv_w[1024 + c], x1 = I.hy_conv_w[3072 + 1024 + c], x2 = I.hy_conv_w[6144 + 1024 + c], xb = I.hy_conv_b[1024 + c];
            const bf16_t* vrow = UT + (size_t)c * TOK; const bf16_t* xrow = UT + (size_t)(1024 + c) * TOK;
#pragma unroll
            for (int k = 0; k < 4; ++k) {
                const int i = tid + 512 * k, b = i >> 8, t0 = (i & 255) * 8;
                *(LAS u32x4*)(lds + hy_zrow(b) + (96 + t0) * 2) = hy_conv8(vrow + (size_t)b * SEQ, t0, w0, w1, w2, bs);
                *(LAS u32x4*)(lds + HY_GATE + (b * SEQ + t0) * 2) = hy_conv8(xrow + (size_t)b * SEQ, t0, x0, x1, x2, xb);
            }
            *(LAS u32x4*)(lds + HY_RAW + tid * 16) = *(const u32x4*)(KREV + (size_t)c * 4096 + tid * 8);
        }
        __syncthreads();
        hy_build_tc(lds, tid);
        __syncthreads();
        f32x16 acc0, acc1;
        hy_conv(lds, wave, lane, acc0, acc1);
        __syncthreads();
        const u32x4 rawn = *(const u32x4*)(KREV + (size_t)(1024 + c) * 4096 + tid * 8);
        {
            const float sk = I.hy_skip[c];
#pragma unroll
            for (int g = 0; g < 2; ++g)
#pragma unroll
                for (int q = 0; q < 4; ++q) {
                    const int t0 = 32 * (4 * (2 * wave + g) + il) + 8 * q + 4 * hi;
                    LAS u32x2* zp = (LAS u32x2*)(lds + hy_zrow(bb) + (96 + t0) * 2);
                    const u32x2 vz = *zp, gx = *(const LAS u32x2*)(lds + HY_GATE + (bb * SEQ + t0) * 2);
                    float a[4];
#pragma unroll
                    for (int j = 0; j < 4; ++j) a[j] = (g == 0) ? acc0[4 * q + j] : acc1[4 * q + j];
                    u32x2 o; o.x = pk2(bflo(gx.x) * (a[0] + bflo(vz.x) * sk), bfhi(gx.x) * (a[1] + bfhi(vz.x) * sk)); o.y = pk2(bflo(gx.y) * (a[2] + bflo(vz.y) * sk), bfhi(gx.y) * (a[3] + bfhi(vz.y) * sk));
                    *zp = o;
                }
        }
        *(LAS u32x4*)(lds + HY_RAW + tid * 16) = rawn;
        __syncthreads();
        {
            const float x0 = I.hy_conv_w[2048 + c], x1 = I.hy_conv_w[3072 + 2048 + c], x2 = I.hy_conv_w[6144 + 2048 + c], xb = I.hy_conv_b[2048 + c];
            const bf16_t* xrow = UT + (size_t)(2048 + c) * TOK;
#pragma unroll
            for (int k = 0; k < 4; ++k) { const int i = tid + 512 * k, b = i >> 8, t0 = (i & 255) * 8; *(LAS u32x4*)(lds + HY_GATE + (b * SEQ + t0) * 2) = hy_conv8(xrow + (size_t)b * SEQ, t0, x0, x1, x2, xb); }
        }
        hy_build_tc(lds, tid);
        __syncthreads();
        hy_conv(lds, wave, lane, acc0, acc1);
        {
            const float sk = I.hy_skip[1024 + c];
            bf16_t* orow = Z2T + (size_t)c * TOK + (size_t)bb * SEQ;
#pragma unroll
            for (int g = 0; g < 2; ++g)
#pragma unroll
                for (int q = 0; q < 4; ++q) {
                    const int t0 = 32 * (4 * (2 * wave + g) + il) + 8 * q + 4 * hi;
                    const u32x2 vz = *(const LAS u32x2*)(lds + hy_zrow(bb) + (96 + t0) * 2), gx = *(const LAS u32x2*)(lds + HY_GATE + (bb * SEQ + t0) * 2);
                    float a[4];
#pragma unroll
                    for (int j = 0; j < 4; ++j) a[j] = (g == 0) ? acc0[4 * q + j] : acc1[4 * q + j];
                    u32x2 o; o.x = pk2(bflo(gx.x) * (a[0] + bflo(vz.x) * sk), bfhi(gx.x) * (a[1] + bfhi(vz.x) * sk)); o.y = pk2(bflo(gx.y) * (a[2] + bflo(vz.y) * sk), bfhi(gx.y) * (a[3] + bfhi(vz.y) * sk));
                    *(u32x2*)(orow + t0) = o;
                }
        }
    }
}
__device__ __forceinline__ void phase_transpose_z2(unsigned char* ws, LAS unsigned char* lds, int lane, int wave, int gw, int NGW) {
    const bf16_t* Z2T = (const bf16_t*)(ws + WS_R2); bf16_t* Z2 = (bf16_t*)(ws + WS_R2 + 32 * MiB);
    LAS bf16_t* scr = (LAS bf16_t*)(lds + wave * 8704);
    for (int it = gw; it < 16 * 256; it += NGW) {
        const int c0 = (it & 15) * 64, t0 = (it >> 4) * 64;
#pragma unroll
        for (int i = 0; i < 8; ++i) {
            const int cc = (lane >> 3) + 8 * i; const u32x4 v = *(const u32x4*)(Z2T + (size_t)(c0 + cc) * TOK + t0 + 8 * (lane & 7));
            LAS unsigned* d = (LAS unsigned*)(scr + cc * 68 + 8 * (lane & 7)); d[0] = v.x; d[1] = v.y; d[2] = v.z; d[3] = v.w;
        }
        LDS_WAIT(); asm volatile("" ::: "memory");
#pragma unroll
        for (int i = 0; i < 8; ++i) {
            const int tt = (lane >> 3) + 8 * i, cb = 8 * (lane & 7);
            unsigned short e[8];
#pragma unroll
            for (int q = 0; q < 8; ++q) e[q] = scr[(cb + q) * 68 + tt];
            u32x4 w; w.x = e[0] | ((unsigned)e[1] << 16); w.y = e[2] | ((unsigned)e[3] << 16); w.z = e[4] | ((unsigned)e[5] << 16); w.w = e[6] | ((unsigned)e[7] << 16);
            *(u32x4*)(Z2 + (size_t)(t0 + tt) * DM + c0 + cb) = w;
        }
        LDS_WAIT(); asm volatile("" ::: "memory");
    }
}

#ifndef DIAG
#define DIAG 0
#endif
#if DIAG
constexpr int CW_CK = 3200;
__device__ __forceinline__ void diag_cksum(unsigned char* ws, int slot, const void* p, size_t bytes, int gw, int NGW, int lane) {
    const u32x4* q = (const u32x4*)p; const size_t n = bytes / 16; unsigned x = 0u;
    for (size_t i = (size_t)gw * 64 + lane; i < n; i += (size_t)NGW * 64) { const u32x4 v = q[i]; x ^= v.x ^ (v.y * 3u) ^ (v.z * 5u) ^ (v.w * 7u) ^ (unsigned)i * 2654435761u * (v.x + v.w); }
#pragma unroll
    for (int o = 1; o < 64; o <<= 1) x ^= (unsigned)__shfl_xor((int)x, o);
    if (lane == 0) atomicXor((unsigned*)(ws + WS_CTL) + CW_CK + slot, x);
}
#define DIAG_CK(slot, ptr, bytes) diag_cksum(ws, slot, ptr, bytes, gw, NGW, lane)
#else
#define DIAG_CK(slot, ptr, bytes) do { } while (0)
#endif
struct Args { const float* in[28]; float* out; unsigned char* ws; int ph_lo, ph_hi; };
static_assert(sizeof(Args) == 28 * 8 + 8 + 8 + 8, "Args has no padding");

__global__ void __launch_bounds__(512, 2) mega_fwd(Args args) {
    extern __shared__ __attribute__((aligned(16))) unsigned char lds_raw[];
    LAS unsigned char* lds = (LAS unsigned char*)lds_raw;
    typedef const __attribute__((address_space(4))) Args* KArgP;
    KArgP kap0 = (KArgP)__builtin_amdgcn_kernarg_segment_ptr();
    volatile LAS unsigned* MISC = (volatile LAS unsigned*)(lds + MISC_OFF);
    const int wave0 = __builtin_amdgcn_readfirstlane((int)threadIdx.x >> 6);
    if (wave0 == 0 && lane_id() < 32) MISC[lane_id()] = 0u;
    __syncthreads();
    const int lo = args.ph_lo, hi = args.ph_hi;
    XcdBarrier bar; bar.bar = (unsigned*)(args.ws + WS_CTL) + CW_BAR; bar.x = 0; bar.st = nullptr;
    if (hi - lo > 1) bar = xcd_barrier_post((unsigned*)(args.ws + WS_CTL) + CW_BAR, MISC + 8, wave0);
#define PHASE_BEGIN() KArgP kap = kap0; asm volatile("" : "+s"(kap)); int lane = lane_id(); asm volatile("" : "+v"(lane)); \
    const int wave = wave0, tid = wave * 64 + lane, bid = blockIdx.x, G = gridDim.x, gw = bid * 8 + wave, NGW = G * 8; \
    unsigned char* ws = kap->ws; const char* wsc = (const char*)ws; In I; \
    I.x = kap->in[0]; I.c = kap->in[1]; I.ctx = kap->in[2]; I.c_ctx = kap->in[3]; I.mod_w = kap->in[4]; I.mod_b = kap->in[5]; I.ln_g = kap->in[6]; I.ln_b = kap->in[7]; \
    I.attn_w_in = kap->in[8]; I.attn_lambda = kap->in[9]; I.attn_subln_g = kap->in[10]; I.attn_sink = kap->in[11]; I.attn_w_out = kap->in[12]; \
    I.hy_w_in = kap->in[13]; I.hy_conv_w = kap->in[14]; I.hy_conv_b = kap->in[15]; I.hy_ffn_w_in = kap->in[16]; I.hy_ffn_w_hid = kap->in[17]; I.hy_ffn_b = kap->in[18]; \
    I.hy_sin_freq = kap->in[19]; I.hy_ffn_w_out = kap->in[20]; I.hy_skip = kap->in[21]; I.hy_w_out = kap->in[22]; I.router_w = kap->in[23]; I.router_bias = kap->in[24]; \
    I.exp_w_gate = kap->in[25]; I.exp_w_up = kap->in[26]; I.exp_w_down = kap->in[27]; (void)wsc; (void)I; (void)lane; (void)wave; (void)gw; (void)NGW
#ifndef DUP_MASK
#define DUP_MASK 0
#endif
#define REP(k) for (int rep_ = 0; rep_ < 1 + (((DUP_MASK) >> (k)) & 1); ++rep_)
#define IN_PH(k) ((((PHASE_MASK) >> (k)) & 1) && lo <= (k) && (k) < hi)
#define SEAM(k) do { if (IN_PH(k) && IN_PH((k) + 1)) xcd_barrier(bar, wave0); else __syncthreads(); } while (0)
#define ONE_SEG(S, a, b, na, nb, fa) pg8::SegSched S; S.nseg = 1; S.G = G; S.c = bid; S.s[0] = pg8::Seg{a, b, na, nb, fa, 0}; S.s[1] = S.s[0]; S.s[2] = S.s[0]; S.s[3] = S.s[0]

    if (IN_PH(0)) { REP(0) { PHASE_BEGIN(); phase_prep(I, ws, lds, tid, lane, wave, bid, G); __syncthreads(); } SEAM(0); }
    if (IN_PH(1)) { REP(1) { PHASE_BEGIN(); DIAG_CK(0, ws + WS_MOD, 442368); phase_modulate0(I, ws, lane, gw, NGW); } SEAM(1); }
    if (IN_PH(2)) { REP(2) {
        PHASE_BEGIN();
        pg8::SegSched S; S.nseg = 4; S.G = G; S.c = bid;
        S.s[0] = pg8::Seg{wsc + WS_HA, wsc + WS_WQK, 64, 7, 1, 0};
        S.s[1] = pg8::Seg{wsc + WS_WV, wsc + WS_HA, 3, 64, 0, 2};
        S.s[2] = pg8::Seg{wsc + WS_Y, wsc + WS_WQK + 4 * pg8::TSTEP, 8, 3, 1, 1};
        S.s[3] = pg8::Seg{wsc + WS_WV, wsc + WS_Y, 3, 8, 0, 3};
        EpiProj E; E.P.QA = (bf16_t*)(ws + WS_R2 + R2_QA); E.P.QW = (bf16_t*)(ws + WS_R2 + R2_QW); E.P.KA = (bf16_t*)(ws + WS_R2 + R2_KA); E.P.VAT = (bf16_t*)(ws + WS_R2 + R2_VAT);
        E.P.KW = (bf16_t*)(ws + WS_R2 + R2_KW); E.P.VWT = (bf16_t*)(ws + WS_R2 + R2_VWT); E.P.rope = (const float*)(ws + WS_ROPE);
        pg8::gemm_phase(lds, S, E, tid); } SEAM(2);
    }
    if (IN_PH(3)) { REP(3) {
        PHASE_BEGIN(); DIAG_CK(1, ws + WS_R2, 77 * MiB);
        const bf16_t* QA = (const bf16_t*)(ws + WS_R2 + R2_QA); const bf16_t* QW = (const bf16_t*)(ws + WS_R2 + R2_QW); const bf16_t* KA = (const bf16_t*)(ws + WS_R2 + R2_KA);
        const bf16_t* VAT = (const bf16_t*)(ws + WS_R2 + R2_VAT); const bf16_t* KW = (const bf16_t*)(ws + WS_R2 + R2_KW); const bf16_t* VWT = (const bf16_t*)(ws + WS_R2 + R2_VWT);
        bf16_t* CAT = (bf16_t*)(ws + WS_BIG);
        float sa = 0.f, sb = 0.f;
        { const float a = I.attn_lambda[lane] * I.attn_lambda[64 + lane], b2 = I.attn_lambda[128 + lane] * I.attn_lambda[192 + lane]; sa = wave_sum(a); sb = wave_sum(b2); }
        const float lam = expf(sa) - expf(sb) + 0.2f;
        for (int u = bid; u < 256; u += G) { const int b = u >> 5, h = (u >> 3) & 3, qb = u & 7; diff_attn_block(lds, QA, KA, VAT, CAT, I.attn_subln_g, lam, b, h, qb, wave, lane); }
        for (int u = bid; u < 512; u += G) { const int b = u >> 6, hkv = (u >> 5) & 1, qblk = u & 31; win_attn_block(lds, QW, KW, VWT, CAT, I.attn_sink, b, hkv, qblk, wave, lane); }
        } SEAM(3);
    }
    if (IN_PH(4)) { REP(4) {
        PHASE_BEGIN(); DIAG_CK(2, ws + WS_BIG, 32 * MiB);
        ONE_SEG(S, wsc + WS_BIG, wsc + WS_WO, 64, 4, 1);
        EpiRowBf16 E{(bf16_t*)(ws + WS_Y), DM};
        pg8::gemm_phase(lds, S, E, tid); } SEAM(4);
    }
#define MOE_LAYER(l, pb) \
    if (IN_PH(pb)) { PHASE_BEGIN(); if (l == 0) DIAG_CK(3, ws + WS_Y, 32 * MiB); phase_ln1_router(I, ws, lds, l, tid, lane, wave, gw, NGW); SEAM(pb); } \
    if (IN_PH(pb + 2)) { REP(pb + 2) { PHASE_BEGIN(); if (l == 0) DIAG_CK(4, ws + WS_XR, 32 * MiB); build_moe_tabs(ws, lds, l, tid, bid, G, true); \
        pg8::MoeSched S{wsc + WS_HA, wsc + WS_WGU + (size_t)l * 64 * MiB, (const LAS int*)(lds + RBTAB_OFF), 8, G, bid, true}; \
        EpiGateUp E{(bf16_t*)(ws + WS_BIG)}; \
        pg8::gemm_phase<EpiGateUp, pg8::MoeSched, true>(lds, S, E, tid, (const LAS unsigned*)(lds + GTAB_OFF)); } SEAM(pb + 2); } \
    if (IN_PH(pb + 3)) { REP(pb + 3) { PHASE_BEGIN(); build_moe_tabs(ws, lds, l, tid, bid, G, false); \
        pg8::MoeSched S{wsc + WS_BIG, wsc + WS_WD + (size_t)l * 32 * MiB, (const LAS int*)(lds + RBTAB_OFF), 4, G, bid, false}; \
        EpiDown E{(bf16_t*)(ws + WS_R2), (const int*)(ws + WS_SLOT), (const float*)(ws + WS_SLOT + MiB), (const LAS int*)(lds + RBTAB_OFF) + 160, (const LAS int*)(lds + RBTAB_OFF) + 320}; \
        pg8::gemm_phase(lds, S, E, tid); } SEAM(pb + 3); } \
    if (IN_PH(pb + 4)) { PHASE_BEGIN(); if (l == 0) DIAG_CK(5, ws + WS_R2, 64 * MiB); phase_ln2(I, ws, l, kap->out, lane, gw, NGW); SEAM(pb + 4); }

    MOE_LAYER(0, 5)
    if (IN_PH(10)) { REP(10) {
        PHASE_BEGIN(); DIAG_CK(6, ws + WS_XR, 32 * MiB);
        ONE_SEG(S, wsc + WS_HIN, wsc + WS_HA, 12, 64, 0);
        EpiRowBf16 E{(bf16_t*)(ws + WS_BIG), TOK};
        pg8::gemm_phase(lds, S, E, tid); } SEAM(10);
    }
    if (IN_PH(11)) { REP(11) { PHASE_BEGIN(); phase_hyena(I, ws, lds, tid, lane, wave, bid, G); __syncthreads(); } SEAM(11); }
    if (IN_PH(12)) { REP(12) { PHASE_BEGIN(); phase_transpose_z2(ws, lds, lane, wave, gw, NGW); } SEAM(12); }
    if (IN_PH(13)) { REP(13) {
        PHASE_BEGIN();
        ONE_SEG(S, wsc + WS_R2 + 32 * MiB, wsc + WS_HOUT, 64, 4, 1);
        EpiRowBf16 E{(bf16_t*)(ws + WS_Y), DM};
        pg8::gemm_phase(lds, S, E, tid); } SEAM(13);
    }
    MOE_LAYER(1, 14)
#if DIAG
    if (hi - lo > 1) {
        xcd_barrier(bar, wave0);
        { PHASE_BEGIN(); DIAG_CK(7, kap->out, (size_t)TOK * DM * 4); }
        xcd_barrier(bar, wave0);
        { PHASE_BEGIN(); (void)tid;
          unsigned* ck = (unsigned*)(ws + WS_CTL) + CW_CK; unsigned* st = (unsigned*)(ws + WS_ROUTE);
          unsigned code = __hip_atomic_load(st + 8, __ATOMIC_RELAXED, __HIP_MEMORY_SCOPE_AGENT);
          if (code == 0xAAAAAAAAu) code = 0u;
          if (code == 0u) { for (int k = 7; k >= 0; --k) { const unsigned pv = __hip_atomic_load(st + k, __ATOMIC_RELAXED, __HIP_MEMORY_SCOPE_AGENT), cv = __hip_atomic_load(ck + k, __ATOMIC_RELAXED, __HIP_MEMORY_SCOPE_AGENT); if (pv != 0xAAAAAAAAu && pv != cv) code = (unsigned)k + 1u; } }
          xcd_barrier(bar, wave0);
          if (bid == 0 && wave == 0 && lane == 0) { for (int k = 0; k < 8; ++k) st[k] = __hip_atomic_load(ck + k, __ATOMIC_RELAXED, __HIP_MEMORY_SCOPE_AGENT); st[8] = code; }
          if (code) { const int nrows = 1024 * (int)code; for (int row = gw; row < nrows; row += NGW) for (int j = lane; j < DM; j += 64) kap->out[(size_t)row * DM + j] = 0.f; }
        }
    }
#endif
#undef IN_PH
#undef SEAM
}

extern "C" void kernel_launch(void* const* d_in, const int* in_sizes, int n_in, void* d_out, int out_size, void* d_ws, size_t ws_size, hipStream_t stream) {
    static int grid = 0;
    if (grid == 0) {
        if (n_in != 28 || in_sizes[0] != TOK * DM || out_size != TOK * DM || ws_size < WS_END) {
            fprintf(stderr, "kernel_launch: unexpected problem (n_in %d, in0 %d, out %d, ws %zu < %zu); nothing launched\n", n_in, n_in > 0 ? in_sizes[0] : -1, out_size, ws_size, (size_t)WS_END); grid = -1; return; }
        int dev = 0, cus = 0, per_cu = 0;
        if (hipGetDevice(&dev) != hipSuccess || hipDeviceGetAttribute(&cus, hipDeviceAttributeMultiprocessorCount, dev) != hipSuccess) { fprintf(stderr, "kernel_launch: device query failed\n"); grid = -1; return; }
        if (hipFuncSetAttribute((const void*)mega_fwd, hipFuncAttributeMaxDynamicSharedMemorySize, LDS_BYTES) != hipSuccess) { fprintf(stderr, "kernel_launch: hipFuncSetAttribute failed\n"); grid = -1; return; }
        if (hipOccupancyMaxActiveBlocksPerMultiprocessor(&per_cu, (const void*)mega_fwd, 512, LDS_BYTES) != hipSuccess || per_cu < 1)
            fprintf(stderr, "kernel_launch: note: occupancy query reports %d workgroups per CU\n", per_cu);
        (void)hipGetLastError();
        grid = cus;
    }
    if (grid < 0) return;
    if (hipMemsetAsync((char*)d_ws + WS_CTL, 0, CTL_ZERO_BYTES, stream) != hipSuccess) { fprintf(stderr, "kernel_launch: memset failed\n"); return; }
    Args a{};
    for (int i = 0; i < 28; ++i) a.in[i] = (const float*)d_in[i];
    a.out = (float*)d_out; a.ws = (unsigned char*)d_ws;
    if (MK_N_LAUNCHES == 1) { a.ph_lo = 0; a.ph_hi = NPH; hipLaunchKernelGGL(mega_fwd, dim3(grid), dim3(512), LDS_BYTES, stream, a); }
    else for (int p = 0; p < NPH; ++p) { a.ph_lo = p; a.ph_hi = p + 1; hipLaunchKernelGGL(mega_fwd, dim3(grid), dim3(512), LDS_BYTES, stream, a); }
    const hipError_t le = hipPeekAtLastError();
    if (le != hipSuccess) fprintf(stderr, "kernel_launch: launch failed: %s\n", hipGetErrorName(le));
}
```
